# Optimizing an MI355X kernel written in HIP

```python
import math
import jax, jax.numpy as jnp
from jax import lax
import numpy as np

D_MODEL = 1024
BATCH = 8
SEQ = 2048
DEPTH = 1
DEC_BATCH = 128
DEC_SEQ = 1
PAST_LEN = 16384
PAGE_SIZE = 128

GDN_HEADS = 8
GDN_DK = 128
GDN_DV = 128
GDN_CONV = 4
CHUNK = 64
QK_W = GDN_HEADS * GDN_DK
V_W = GDN_HEADS * GDN_DV
QKV_W = 2 * QK_W + V_W
SC_W = 1024
SC_GROUPS = 8
SC_CONV = 3
FFN_HIDDEN = 2816
PLE_DIM = 256
IN_SPLITS = (QKV_W, V_W, GDN_HEADS, GDN_HEADS, SC_W, SC_W, SC_W, D_MODEL, D_MODEL)
IN_W = QKV_W + V_W + 2 * GDN_HEADS + 3 * SC_W + 2 * D_MODEL
DEEPNORM_ALPHA = (2.0 * DEPTH) ** 0.25
DEEPNORM_BETA = (8.0 * DEPTH) ** -0.25
LN_EPS = 1e-5
RMS_EPS = 1e-6
L2_EPS = 1e-6

kernel_name = "hybrid_gdn_shortconv_macaron_deepnorm_step"


def split_cols(a, widths):
    out = []
    s = 0
    for wd in widths:
        out.append(a[..., s:s + wd])
        s += wd
    return out


def layer_norm(x, g, b):
    xf = x.astype(jnp.float32)
    mu = jnp.mean(xf, -1, keepdims=True)
    var = jnp.mean(jnp.square(xf - mu), -1, keepdims=True)
    return ((xf - mu) * lax.rsqrt(var + LN_EPS) * g.astype(jnp.float32) + b.astype(jnp.float32)).astype(x.dtype)


def swiglu(x, w_gate, w_up, w_down):
    return (jax.nn.silu(x @ w_gate) * (x @ w_up)) @ w_down


def causal_dwconv(x, buf, w):
    width = w.shape[0]
    t = x.shape[1]
    xp = jnp.concatenate([buf.astype(x.dtype), x], axis=1)
    y = sum(xp[:, j:j + t] * w[j] for j in range(width))
    return y, xp[:, -(width - 1):]


def l2norm(x):
    return x * lax.rsqrt(jnp.sum(jnp.square(x), -1, keepdims=True) + L2_EPS)


def gdn_chunked(q, k, v, g, beta, s0):
    b, t, h, _ = q.shape
    dv = v.shape[-1]
    n = t // CHUNK
    c = CHUNK

    def blk(a):
        return a.reshape(b, n, c, h, -1).transpose(1, 0, 3, 2, 4)

    q, k, v = blk(q), blk(k), blk(v)
    g = g.reshape(b, n, c, h).transpose(1, 0, 3, 2)
    beta = beta.reshape(b, n, c, h).transpose(1, 0, 3, 2)
    gc = jnp.cumsum(g, axis=-1)
    tril = jnp.tril(jnp.ones((c, c), bool))
    strict = jnp.tril(jnp.ones((c, c), bool), -1)
    decay = jnp.where(tril, jnp.exp(jnp.where(tril, gc[..., :, None] - gc[..., None, :], 0.0)), 0.0)
    kb = k * beta[..., None]
    m = jnp.where(strict, jnp.einsum("nbhik,nbhjk->nbhij", kb, k) * decay, 0.0)
    a = m + jnp.eye(c, dtype=m.dtype)
    u = lax.linalg.triangular_solve(a, v * beta[..., None], left_side=True, lower=True, unit_diagonal=True)
    w = lax.linalg.triangular_solve(a, kb * jnp.exp(gc)[..., None], left_side=True, lower=True, unit_diagonal=True)
    qk = jnp.einsum("nbhik,nbhjk->nbhij", q, k) * decay
    g_last = gc[..., -1]
    q_dec = q * jnp.exp(gc)[..., None]
    k_dec = k * jnp.exp(g_last[..., None] - gc)[..., None]

    def step(s, inp):
        u_n, w_n, qk_n, q_n, k_n, gl_n = inp
        v_new = u_n - jnp.einsum("bhck,bhkv->bhcv", w_n, s)
        o = jnp.einsum("bhck,bhkv->bhcv", q_n, s) + jnp.einsum("bhij,bhjv->bhiv", qk_n, v_new)
        s = s * jnp.exp(gl_n)[..., None, None] + jnp.einsum("bhck,bhcv->bhkv", k_n, v_new)
        return s, o

    s, o = lax.scan(step, s0, (u, w, qk, q_dec, k_dec, g_last))
    o = o.transpose(1, 0, 3, 2, 4).reshape(b, t, h, dv)
    return o, s


def gdn_recurrent(q, k, v, g, beta, s0):
    def step(s, inp):
        q_t, k_t, v_t, g_t, b_t = inp
        s = s * jnp.exp(g_t)[..., None, None]
        kv = jnp.einsum("bhk,bhkv->bhv", k_t, s)
        d = (v_t - kv) * b_t[..., None]
        s = s + jnp.einsum("bhk,bhv->bhkv", k_t, d)
        o = jnp.einsum("bhk,bhkv->bhv", q_t, s)
        return s, o

    xs = (jnp.swapaxes(q, 0, 1), jnp.swapaxes(k, 0, 1), jnp.swapaxes(v, 0, 1), jnp.swapaxes(g, 0, 1), jnp.swapaxes(beta, 0, 1))
    s, o = lax.scan(step, s0, xs)
    return jnp.swapaxes(o, 0, 1), s


def token_mixers(x, s0, buf_qkv, buf_sc, w, chunked):
    bsz, t, _ = x.shape
    proj = x @ w["w_in"]
    qkv, z, b_raw, a_raw, gate_b, gate_c, hsc, gate_gdn, gate_sc = split_cols(proj, IN_SPLITS)
    qkv_c, new_buf_qkv = causal_dwconv(qkv, buf_qkv, w["w_conv_qkv"])
    qkv_c = jax.nn.silu(qkv_c).astype(jnp.float32)
    q, k, v = split_cols(qkv_c, (QK_W, QK_W, V_W))
    q = l2norm(q.reshape(bsz, t, GDN_HEADS, GDN_DK)) * (GDN_DK ** -0.5)
    k = l2norm(k.reshape(bsz, t, GDN_HEADS, GDN_DK))
    v = v.reshape(bsz, t, GDN_HEADS, GDN_DV)
    beta = jax.nn.sigmoid(b_raw.astype(jnp.float32))
    g = -jnp.exp(w["A_log"].astype(jnp.float32)) * jax.nn.softplus(a_raw.astype(jnp.float32) + w["dt_bias"].astype(jnp.float32))
    s0 = s0.astype(jnp.float32)
    if chunked:
        o, s_new = gdn_chunked(q, k, v, g, beta, s0)
    else:
        o, s_new = gdn_recurrent(q, k, v, g, beta, s0)
    zf = z.astype(jnp.float32).reshape(bsz, t, GDN_HEADS, GDN_DV)
    o = o * lax.rsqrt(jnp.mean(jnp.square(o), -1, keepdims=True) + RMS_EPS) * w["w_onorm"].astype(jnp.float32) * jax.nn.silu(zf)
    branch_gdn = o.reshape(bsz, t, V_W).astype(x.dtype) @ w["w_p_gdn"]
    u_c, new_buf_sc = causal_dwconv(gate_c * hsc, buf_sc, w["w_conv_sc"])
    branch_sc = (gate_b * u_c) @ w["w_p_sc"]
    merged = jax.nn.sigmoid(gate_gdn) * branch_gdn + jax.nn.sigmoid(gate_sc) * branch_sc
    return merged @ w["w_o"], s_new, new_buf_qkv, new_buf_sc


def decoder_layer(x, p, s0, buf_qkv, buf_sc, w, chunked):
    x = layer_norm(DEEPNORM_ALPHA * x + 0.5 * swiglu(x, w["ffn1_w_gate"], w["ffn1_w_up"], w["ffn1_w_down"]), w["ln1_g"], w["ln1_b"])
    mix, s_new, nb_qkv, nb_sc = token_mixers(x, s0, buf_qkv, buf_sc, w, chunked)
    x = layer_norm(DEEPNORM_ALPHA * x + mix, w["ln2_g"], w["ln2_b"])
    x = layer_norm(DEEPNORM_ALPHA * x + 0.5 * swiglu(x, w["ffn2_w_gate"], w["ffn2_w_up"], w["ffn2_w_down"]), w["ln3_g"], w["ln3_b"])
    ple = jax.nn.sigmoid(x @ w["w_ple_gate"]) * (p.astype(x.dtype) @ w["w_ple_proj"])
    x = layer_norm(DEEPNORM_ALPHA * x + ple, w["ln4_g"], w["ln4_b"])
    return x, s_new, nb_qkv, nb_sc


def setup_inputs(seed: int = 0) -> dict:
    key = jax.random.key(seed)
    ks = iter(jax.random.split(key, 48))

    def nrm(shape, scale):
        return jax.random.normal(next(ks), shape, jnp.float32) * scale

    def gain():
        return 1.0 + nrm((DEPTH, D_MODEL), 0.02)

    def bias():
        return nrm((DEPTH, D_MODEL), 0.02)

    A_log = jnp.log(jax.random.uniform(next(ks), (DEPTH, GDN_HEADS), jnp.float32, 1.0, 16.0))
    dt = jnp.exp(jax.random.uniform(next(ks), (DEPTH, GDN_HEADS), jnp.float32, math.log(1e-3), math.log(1e-1)))
    dt_bias = dt + jnp.log(-jnp.expm1(-dt))
    return {
        "x_prompt": nrm((BATCH, SEQ, D_MODEL), 1.0),
        "x_sample": nrm((DEC_BATCH, DEC_SEQ, D_MODEL), 1.0),
        "p_prompt": nrm((DEPTH, BATCH, SEQ, PLE_DIM), 1.0),
        "p_sample": nrm((DEPTH, DEC_BATCH, DEC_SEQ, PLE_DIM), 1.0),
        "state_gdn": nrm((DEPTH, DEC_BATCH, GDN_HEADS, GDN_DK, GDN_DV), 0.1),
        "state_qkv_conv": nrm((DEPTH, DEC_BATCH, GDN_CONV - 1, QKV_W), 1.0),
        "state_sc_conv": nrm((DEPTH, DEC_BATCH, SC_CONV - 1, SC_W), 1.0),
        "ffn1_w_gate": nrm((DEPTH, D_MODEL, FFN_HIDDEN), D_MODEL ** -0.5),
        "ffn1_w_up": nrm((DEPTH, D_MODEL, FFN_HIDDEN), D_MODEL ** -0.5),
        "ffn1_w_down": nrm((DEPTH, FFN_HIDDEN, D_MODEL), FFN_HIDDEN ** -0.5 * DEEPNORM_BETA),
        "ln1_g": gain(),
        "ln1_b": bias(),
        "w_in": nrm((DEPTH, D_MODEL, IN_W), D_MODEL ** -0.5),
        "w_conv_qkv": nrm((DEPTH, GDN_CONV, QKV_W), GDN_CONV ** -0.5),
        "A_log": A_log,
        "dt_bias": dt_bias,
        "w_onorm": 1.0 + nrm((DEPTH, GDN_DV), 0.02),
        "w_p_gdn": nrm((DEPTH, V_W, D_MODEL), V_W ** -0.5 * DEEPNORM_BETA),
        "w_conv_sc": nrm((DEPTH, SC_CONV, SC_W), SC_CONV ** -0.5),
        "w_p_sc": nrm((DEPTH, SC_W, D_MODEL), SC_W ** -0.5 * DEEPNORM_BETA),
        "w_o": nrm((DEPTH, D_MODEL, D_MODEL), D_MODEL ** -0.5 * DEEPNORM_BETA),
        "ln2_g": gain(),
        "ln2_b": bias(),
        "ffn2_w_gate": nrm((DEPTH, D_MODEL, FFN_HIDDEN), D_MODEL ** -0.5),
        "ffn2_w_up": nrm((DEPTH, D_MODEL, FFN_HIDDEN), D_MODEL ** -0.5),
        "ffn2_w_down": nrm((DEPTH, FFN_HIDDEN, D_MODEL), FFN_HIDDEN ** -0.5 * DEEPNORM_BETA),
        "ln3_g": gain(),
        "ln3_b": bias(),
        "w_ple_gate": nrm((DEPTH, D_MODEL, D_MODEL), D_MODEL ** -0.5),
        "w_ple_proj": nrm((DEPTH, PLE_DIM, D_MODEL), PLE_DIM ** -0.5 * DEEPNORM_BETA),
        "ln4_g": gain(),
        "ln4_b": bias(),
    }


def reference(x_prompt, x_sample, p_prompt, p_sample, state_gdn, state_qkv_conv, state_sc_conv,
              ffn1_w_gate, ffn1_w_up, ffn1_w_down, ln1_g, ln1_b,
              w_in, w_conv_qkv, A_log, dt_bias, w_onorm, w_p_gdn, w_conv_sc, w_p_sc, w_o, ln2_g, ln2_b,
              ffn2_w_gate, ffn2_w_up, ffn2_w_down, ln3_g, ln3_b,
              w_ple_gate, w_ple_proj, ln4_g, ln4_b):
    xp = x_prompt
    xs = x_sample
    sp_gdn, sp_qkv, sp_sc = [], [], []
    ss_gdn, ss_qkv, ss_sc = [], [], []
    for i in range(DEPTH):
        w = {
            "ffn1_w_gate": ffn1_w_gate[i], "ffn1_w_up": ffn1_w_up[i], "ffn1_w_down": ffn1_w_down[i],
            "ln1_g": ln1_g[i], "ln1_b": ln1_b[i],
            "w_in": w_in[i], "w_conv_qkv": w_conv_qkv[i], "A_log": A_log[i], "dt_bias": dt_bias[i],
            "w_onorm": w_onorm[i], "w_p_gdn": w_p_gdn[i], "w_conv_sc": w_conv_sc[i], "w_p_sc": w_p_sc[i],
            "w_o": w_o[i], "ln2_g": ln2_g[i], "ln2_b": ln2_b[i],
            "ffn2_w_gate": ffn2_w_gate[i], "ffn2_w_up": ffn2_w_up[i], "ffn2_w_down": ffn2_w_down[i],
            "ln3_g": ln3_g[i], "ln3_b": ln3_b[i],
            "w_ple_gate": w_ple_gate[i], "w_ple_proj": w_ple_proj[i], "ln4_g": ln4_g[i], "ln4_b": ln4_b[i],
        }
        s0 = jnp.zeros((BATCH, GDN_HEADS, GDN_DK, GDN_DV), jnp.float32)
        b_qkv = jnp.zeros((BATCH, GDN_CONV - 1, QKV_W), xp.dtype)
        b_sc = jnp.zeros((BATCH, SC_CONV - 1, SC_W), xp.dtype)
        xp, s_n, q_n, c_n = decoder_layer(xp, p_prompt[i], s0, b_qkv, b_sc, w, True)
        sp_gdn.append(s_n)
        sp_qkv.append(q_n)
        sp_sc.append(c_n)
        xs, s_n, q_n, c_n = decoder_layer(xs, p_sample[i], state_gdn[i], state_qkv_conv[i], state_sc_conv[i], w, False)
        ss_gdn.append(s_n)
        ss_qkv.append(q_n)
        ss_sc.append(c_n)
    return (xp, xs, jnp.stack(sp_gdn), jnp.stack(sp_qkv), jnp.stack(sp_sc), jnp.stack(ss_gdn), jnp.stack(ss_qkv), jnp.stack(ss_sc))
```

```cpp
#include <hip/hip_runtime.h>
#include <hip/hip_cooperative_groups.h>
#include <cstdio>
#include <cstdint>
namespace cg = cooperative_groups;
namespace pg8 {
#define PG8_LAS __attribute__((address_space(3)))
typedef unsigned short bf16_t;
typedef short bf16x8 __attribute__((ext_vector_type(8)));
typedef float f32x4 __attribute__((ext_vector_type(4)));
typedef unsigned u32x4 __attribute__((ext_vector_type(4)));
constexpr int BM = 256, BK = 64, HALF = 128, HTB = HALF * BK * 2  , STAGE_BYTES = 8 * HTB, NXCD = 8, WGM = 8;

__host__ __device__ __forceinline__ int lds_byte(int r, int c) { const int st = (r >> 4) * 2 + (c >> 5), rr = r & 15, cc = c & 31, ob = rr * 64 + cc * 2; return st * 1024 + (ob ^ (((ob >> 9) & 1) << 5)); }
__host__ __device__ __forceinline__ void stage_rc(int b, int& R, int& C) { const int st = b / 1024, sb = b % 1024, swz = sb ^ (((sb >> 9) & 1) << 5); R = (st >> 1) * 16 + swz / 64; C = (st & 1) * 32 + (swz % 64) / 2; }
__host__ __device__ __forceinline__ int perm32(int rho) { const int n = rho >> 4, i = rho & 15; return 8 * (i >> 2) + 4 * n + (i & 3); }

struct Unit { int pm, pn; };
struct Gemm { const bf16_t* A; const bf16_t* Bt; int M, N, K; };

struct StaticOrder {
    int nM, nN, nwg, G, c;
    __host__ __device__ void init(int M, int N, int G_, int c_) { nM = M / BM; nN = N / BM; nwg = nM * nN; G = G_; c = c_; }
    __host__ __device__ bool next(int i, Unit& u) const {
        const long L = (long)i * G + c; if (L >= nwg) return false;
        int wgid = (int)L; { const int q = nwg / NXCD, r = nwg % NXCD, xcd = wgid % NXCD, off = wgid / NXCD; wgid = (xcd < r ? xcd * (q + 1) : r * (q + 1) + (xcd - r) * q) + off; }
        const int nig = WGM * nN, gid = wgid / nig, fm = gid * WGM, gsz = (nM - fm) < WGM ? (nM - fm) : WGM;
        u.pm = fm + ((wgid % nig) % gsz); u.pn = (wgid % nig) / gsz; return true;
    }
    __device__ __forceinline__ void a_ready(const Unit&) const {}
    __device__ __forceinline__ void done(const Unit&) const {}
};

typedef __bf16 bf16x2n __attribute__((ext_vector_type(2)));
__device__ __forceinline__ unsigned cvt_pk_bf16(float lo, float hi) { bf16x2n v; v.x = (__bf16)lo; v.y = (__bf16)hi; return __builtin_bit_cast(unsigned, v); }
typedef float f32x2 __attribute__((ext_vector_type(2)));
template <class Epi, class Sched, bool ALIGN_EPI = false, bool SP2 = false>
__device__ __forceinline__ void gemm_phase(PG8_LAS unsigned char* lds, const Gemm g, const Sched& S, const Epi& E) {
    const int tid = threadIdx.x, wid = __builtin_amdgcn_readfirstlane(tid >> 6), lane = tid & 63, wr = wid >> 2, wc = wid & 3, fr = lane & 15, fq = lane >> 4;
    const int K = g.K, nt = K / BK;
    unsigned voffA[2], voffB[2];
#pragma unroll
    for (int i = 0; i < 2; ++i) { int R, C; stage_rc(tid * 16 + i * 8192, R, C); const int Rb = Epi::PERM ? ((R & ~31) + perm32(R & 31)) : R;
        voffA[i] = (unsigned)(R * K + C) * 2u; voffB[i] = (unsigned)(Rb * K + C) * 2u; }
    const size_t kstep = (size_t)(BK * 2);
    const size_t hstep = (size_t)HALF * K * 2;
    const size_t tstep = 2 * hstep;
    const unsigned ldsw = (unsigned)wid * 1024u;
    const int aoff = lds_byte(wr * 64 + fr, fq * 8), boff = lds_byte(wc * 32 + fr, fq * 8);
#define PG8_SA(b, h) (((b) * 2 + (h)) * HTB)
#define PG8_SB(b, h) ((4 + (b) * 2 + (h)) * HTB)
#define PG8_STAGE(bufoff, gbase, voff) do { _Pragma("unroll") for (int _i = 0; _i < 2; ++_i) \
        __builtin_amdgcn_global_load_lds((const unsigned*)((const char*)(gbase) + (voff)[_i]), (PG8_LAS unsigned*)(lds + (bufoff) + ldsw + _i * 8192), 16, 0, 0); } while (0)
#define PG8_LDA(dst, b, h) do { _Pragma("unroll") for (int m = 0; m < 4; ++m) _Pragma("unroll") for (int k = 0; k < 2; ++k) dst[m][k] = *(const PG8_LAS bf16x8*)(lds + PG8_SA(b, h) + aoff + m * 2048 + k * 1024); } while (0)
#define PG8_LDB(dst, b, h) do { _Pragma("unroll") for (int n = 0; n < 2; ++n) _Pragma("unroll") for (int k = 0; k < 2; ++k) dst[n][k] = *(const PG8_LAS bf16x8*)(lds + PG8_SB(b, h) + boff + n * 2048 + k * 1024); } while (0)
#define PG8_MMA(ai, bj, At, Bt) do { __builtin_amdgcn_s_setprio(1); _Pragma("unroll") for (int m = 0; m < 4; ++m) _Pragma("unroll") for (int n = 0; n < 2; ++n) _Pragma("unroll") for (int k = 0; k < 2; ++k) \
        acc[ai][bj][m][n] = __builtin_amdgcn_mfma_f32_16x16x32_bf16(Bt[n][k], At[m][k], acc[ai][bj][m][n], 0, 0, 0); __builtin_amdgcn_s_setprio(0); } while (0)
#define PG8_WAIT_V(n) asm volatile("s_waitcnt vmcnt(" #n ")" ::: "memory")
#define PG8_WAIT_L(n) asm volatile("s_waitcnt lgkmcnt(" #n ")" ::: "memory")
#define PG8_BAR __builtin_amdgcn_s_barrier()
#define PG8_SCHED __builtin_amdgcn_sched_barrier(0)
    Unit cur, nxt; int ui = 0;
    if (!S.next(0, cur)) return;
    f32x4 acc[2][2][4][2];
#pragma unroll
    for (int a = 0; a < 2; ++a)
#pragma unroll
        for (int b = 0; b < 2; ++b)
#pragma unroll
            for (int m = 0; m < 4; ++m)
#pragma unroll
                for (int n = 0; n < 2; ++n) acc[a][b][m][n] = (f32x4){0.f, 0.f, 0.f, 0.f};
    bf16x8 At[4][2], B0[2][2], B1[2][2];
    const char* cA = (const char*)g.A + (size_t)cur.pm * tstep; const char* cB = (const char*)g.Bt + (size_t)cur.pn * tstep;
    S.a_ready(cur);
    if constexpr (SP2) {
        PG8_STAGE(PG8_SB(0, 0), cB, voffB); PG8_STAGE(PG8_SB(0, 1), cB + hstep, voffB); PG8_STAGE(PG8_SA(0, 0), cA, voffA); PG8_STAGE(PG8_SA(0, 1), cA + hstep, voffA);
        if (wr == 1) PG8_BAR;
        PG8_WAIT_V(2); PG8_BAR;
        PG8_STAGE(PG8_SB(1, 0), cB + kstep, voffB); PG8_STAGE(PG8_SA(1, 0), cA + kstep, voffA); PG8_STAGE(PG8_SB(1, 1), cB + hstep + kstep, voffB);
        PG8_WAIT_V(6); PG8_BAR;
    } else {
        PG8_STAGE(PG8_SB(0, 0), cB, voffB); PG8_STAGE(PG8_SA(0, 0), cA, voffA); PG8_STAGE(PG8_SB(0, 1), cB + hstep, voffB); PG8_STAGE(PG8_SA(0, 1), cA + hstep, voffA);
        if (wr == 1) PG8_BAR;
        PG8_WAIT_V(4); PG8_BAR;
        PG8_STAGE(PG8_SB(1, 0), cB + kstep, voffB); PG8_STAGE(PG8_SA(1, 0), cA + kstep, voffA); PG8_STAGE(PG8_SB(1, 1), cB + hstep + kstep, voffB);
        PG8_WAIT_V(6); PG8_BAR;
    }
    for (;;) {
        const bool has_next = S.next(ui + 1, nxt);
        const char* nA = has_next ? (const char*)g.A + (size_t)nxt.pm * tstep : cA; const char* nB = has_next ? (const char*)g.Bt + (size_t)nxt.pn * tstep : cB;
        for (int t = 0; t < nt; t += 2) {
            const bool last = (t == nt - 2);
            const char* a1 = cA + (size_t)(t + 1) * kstep;
            const char* a2 = last ? nA : cA + (size_t)(t + 2) * kstep; const char* b2 = last ? nB : cB + (size_t)(t + 2) * kstep;
            const char* a3 = a2 + kstep; const char* b3 = b2 + kstep;
            if (last && has_next) S.a_ready(nxt);
            if constexpr (SP2) {
            PG8_LDB(B0, 0, 0); PG8_LDB(B1, 0, 1); PG8_SCHED; PG8_LDA(At, 0, 0); PG8_STAGE(PG8_SA(1, 1), a1 + hstep, voffA);
            PG8_WAIT_V(8); PG8_WAIT_L(0); PG8_BAR; PG8_MMA(0, 0, At, B0); PG8_MMA(0, 1, At, B1); PG8_BAR; PG8_SCHED;
            PG8_LDA(At, 0, 1); PG8_STAGE(PG8_SB(0, 0), b2, voffB); PG8_STAGE(PG8_SB(0, 1), b2 + hstep, voffB); PG8_STAGE(PG8_SA(0, 0), a2, voffA);
            PG8_WAIT_V(8); PG8_WAIT_L(0); PG8_BAR; PG8_MMA(1, 0, At, B0); PG8_MMA(1, 1, At, B1); PG8_BAR; PG8_SCHED;
            PG8_LDB(B0, 1, 0); PG8_LDB(B1, 1, 1); PG8_SCHED; PG8_LDA(At, 1, 0); PG8_STAGE(PG8_SA(0, 1), a2 + hstep, voffA);
            PG8_WAIT_V(8); PG8_WAIT_L(0); PG8_BAR; PG8_MMA(0, 0, At, B0); PG8_MMA(0, 1, At, B1); PG8_BAR; PG8_SCHED;
            PG8_LDA(At, 1, 1); PG8_STAGE(PG8_SB(1, 0), b3, voffB); PG8_STAGE(PG8_SB(1, 1), b3 + hstep, voffB); PG8_STAGE(PG8_SA(1, 0), a3, voffA);
            PG8_WAIT_V(8); PG8_WAIT_L(0); PG8_BAR; PG8_MMA(1, 0, At, B0); PG8_MMA(1, 1, At, B1); PG8_BAR; PG8_SCHED;
            } else {
            PG8_LDB(B0, 0, 0); PG8_SCHED; PG8_LDA(At, 0, 0); PG8_STAGE(PG8_SA(1, 1), a1 + hstep, voffA);
            PG8_WAIT_L(8); PG8_BAR; PG8_WAIT_L(0); PG8_MMA(0, 0, At, B0); PG8_BAR; PG8_SCHED;
            PG8_LDB(B1, 0, 1); PG8_STAGE(PG8_SB(0, 0), b2, voffB);
            PG8_BAR; PG8_WAIT_L(0); PG8_MMA(0, 1, At, B1); PG8_BAR;
            PG8_LDA(At, 0, 1); PG8_STAGE(PG8_SA(0, 0), a2, voffA);
            PG8_BAR; PG8_WAIT_L(0); PG8_MMA(1, 0, At, B0); PG8_BAR; PG8_SCHED;
            PG8_STAGE(PG8_SB(0, 1), b2 + hstep, voffB);
            PG8_WAIT_V(6); PG8_BAR; PG8_MMA(1, 1, At, B1); PG8_BAR;
            PG8_LDB(B0, 1, 0); PG8_SCHED; PG8_LDA(At, 1, 0); PG8_STAGE(PG8_SA(0, 1), a2 + hstep, voffA);
            PG8_WAIT_L(8); PG8_BAR; PG8_WAIT_L(0); PG8_MMA(0, 0, At, B0); PG8_BAR; PG8_SCHED;
            PG8_LDB(B1, 1, 1); PG8_STAGE(PG8_SB(1, 0), b3, voffB);
            PG8_BAR; PG8_WAIT_L(0); PG8_MMA(0, 1, At, B1); PG8_BAR;
            PG8_LDA(At, 1, 1); PG8_STAGE(PG8_SA(1, 0), a3, voffA);
            PG8_BAR; PG8_WAIT_L(0); PG8_MMA(1, 0, At, B0); PG8_BAR; PG8_SCHED;
            PG8_STAGE(PG8_SB(1, 1), b3 + hstep, voffB);
            PG8_WAIT_V(6); PG8_BAR; PG8_MMA(1, 1, At, B1); PG8_BAR;
            }
        }
        if constexpr (ALIGN_EPI) { if (wr == 0) PG8_BAR; }
        if constexpr (!Epi::AFTER_DRAIN) { E(acc, cur, wr, wc, fr, fq); S.done(cur); }
        if (!has_next) break;
#pragma unroll
        for (int a = 0; a < 2; ++a)
#pragma unroll
            for (int b = 0; b < 2; ++b)
#pragma unroll
                for (int m = 0; m < 4; ++m)
#pragma unroll
                    for (int n = 0; n < 2; ++n) acc[a][b][m][n] = (f32x4){0.f, 0.f, 0.f, 0.f};
        cur = nxt; cA = nA; cB = nB; ++ui;
        if constexpr (ALIGN_EPI) { if (wr == 1) PG8_BAR; }
    }
    PG8_WAIT_V(0);
    if constexpr (!ALIGN_EPI) { if (wr == 0) PG8_BAR; }
    PG8_BAR;
    if constexpr (Epi::AFTER_DRAIN) { E.fused(acc, cur, wr, wc, fr, fq, lds, wid, lane); S.done(cur); }
#undef PG8_SA
#undef PG8_SB
#undef PG8_STAGE
#undef PG8_LDA
#undef PG8_LDB
#undef PG8_MMA
#undef PG8_WAIT_V
#undef PG8_WAIT_L
#undef PG8_BAR
#undef PG8_SCHED
}
}

#define LAS __attribute__((address_space(3)))
typedef unsigned short bf16;
typedef pg8::f32x4 f32x4;
typedef pg8::u32x4 u32x4;
typedef pg8::bf16x8 bf16x8;
typedef unsigned u32x2 __attribute__((ext_vector_type(2)));
using pg8::cvt_pk_bf16;

constexpr int D = 1024, FF = 2816, MPROMPT = 16384, MS = 128, MREAL = MPROMPT + MS, MP = 16640;
constexpr int INW = 9232;
constexpr float ALPHA = 1.189207115002721f;
constexpr int NWAVES = 8;
constexpr int LDS_BYTES = 147456;

constexpr size_t UEL = (size_t)MP * 1024;
constexpr size_t UB = UEL * 2;
constexpr size_t WS_WGU = 4096;
constexpr size_t WS_WD = WS_WGU + (size_t)5632 * 1024 * 2;
constexpr size_t WS_WQKV = WS_WD + (size_t)1024 * 2816 * 2;
constexpr size_t WS_WINB = WS_WQKV + (size_t)3072 * 1024 * 2;
constexpr size_t WS_WPG = WS_WINB + (size_t)6144 * 1024 * 2;
constexpr size_t WS_WPS = WS_WPG + 2097152, WS_WO = WS_WPS + 2097152, WS_WPLEG = WS_WO + 2097152, WS_WPLEP = WS_WPLEG + 2097152;
constexpr size_t WS_WBA = WS_WPLEP + 524288;
constexpr size_t WS_XB = WS_WBA + 65536;
constexpr size_t WS_R = WS_XB + UB;
constexpr size_t WS_BETA = WS_R + 5 * UB;
constexpr size_t WS_GG = WS_BETA + (size_t)MP * 32, WS_GC = WS_GG + (size_t)MP * 32, WS_SSQ = WS_GC + (size_t)MP * 32;
constexpr size_t WS_HALO = WS_SSQ + (size_t)MP * 256;
constexpr size_t WS_SQKV = WS_HALO + (size_t)256 * 3 * 3072 * 2;
constexpr size_t WS_END = WS_SQKV + (size_t)128 * 3072 * 4;
static_assert(WS_END <= 268435456, "workspace map must fit 256 MiB");

constexpr size_t O_YP = 0, O_YS = 16777216, O_SPG = 16908288, O_SPQ = 17956864, O_SPC = 18030592, O_SSG = 18046976, O_SSQ = 34824192, O_SSC = 36003840, O_END = 36265984;

__device__ __forceinline__ float bf2f(unsigned short b) { return __uint_as_float((unsigned)b << 16); }
__device__ __forceinline__ unsigned short f2bf(float f) { return (unsigned short)(cvt_pk_bf16(f, 0.f) & 0xffffu); }
__device__ __forceinline__ void unpack8(const u32x4 w, float (&f)[8]) {
    f[0] = __uint_as_float(w.x << 16); f[1] = __uint_as_float(w.x & 0xffff0000u); f[2] = __uint_as_float(w.y << 16); f[3] = __uint_as_float(w.y & 0xffff0000u);
    f[4] = __uint_as_float(w.z << 16); f[5] = __uint_as_float(w.z & 0xffff0000u); f[6] = __uint_as_float(w.w << 16); f[7] = __uint_as_float(w.w & 0xffff0000u);
}
__device__ __forceinline__ u32x4 pack8(const float (&f)[8]) { u32x4 w; w.x = cvt_pk_bf16(f[0], f[1]); w.y = cvt_pk_bf16(f[2], f[3]); w.z = cvt_pk_bf16(f[4], f[5]); w.w = cvt_pk_bf16(f[6], f[7]); return w; }
__device__ __forceinline__ u32x4 pack44(const f32x4 a, const f32x4 b) { u32x4 w; w.x = cvt_pk_bf16(a[0], a[1]); w.y = cvt_pk_bf16(a[2], a[3]); w.z = cvt_pk_bf16(b[0], b[1]); w.w = cvt_pk_bf16(b[2], b[3]); return w; }
__device__ __forceinline__ float sigm(float x) { return __builtin_amdgcn_rcpf(1.f + __expf(-x)); }
__device__ __forceinline__ float silu(float x) { return x * sigm(x); }
__device__ __forceinline__ f32x4 sigm4(f32x4 v) { return (f32x4){sigm(v[0]), sigm(v[1]), sigm(v[2]), sigm(v[3])}; }
__device__ __forceinline__ f32x4 silu4(f32x4 v) { return (f32x4){silu(v[0]), silu(v[1]), silu(v[2]), silu(v[3])}; }
__device__ __forceinline__ f32x4 lo4(const u32x4 w) { return (f32x4){__uint_as_float(w.x << 16), __uint_as_float(w.x & 0xffff0000u), __uint_as_float(w.y << 16), __uint_as_float(w.y & 0xffff0000u)}; }
__device__ __forceinline__ f32x4 hi4(const u32x4 w) { return (f32x4){__uint_as_float(w.z << 16), __uint_as_float(w.z & 0xffff0000u), __uint_as_float(w.w << 16), __uint_as_float(w.w & 0xffff0000u)}; }
__device__ __forceinline__ float wave_sum(float v) {
#pragma unroll
    for (int o = 1; o < 64; o <<= 1) v += __shfl_xor(v, o);
    return v;
}

#define EPI_ROWS_BEGIN const int row0 = u.pm * 256 + wr * 64 + fr; _Pragma("unroll") for (int ai = 0; ai < 2; ++ai) _Pragma("unroll") for (int m = 0; m < 4; ++m) { const int r = row0 + ai * 128 + m * 16;
#define EPI_ROWS_END }

struct EpiGU {
    static constexpr bool PERM = true, AFTER_DRAIN = false;
    bf16* H;
    __device__ __forceinline__ void operator()(const f32x4 (&acc)[2][2][4][2], const pg8::Unit& u, int wr, int wc, int fr, int fq) const {
        const int col = u.pn * 128 + wc * 32 + 8 * fq;
        EPI_ROWS_BEGIN
            const f32x4 h0 = silu4(acc[ai][0][m][0]) * acc[ai][1][m][0], h1 = silu4(acc[ai][0][m][1]) * acc[ai][1][m][1];
            *(u32x4*)(H + (size_t)r * FF + col) = pack44(h0, h1);
        EPI_ROWS_END
    }
};
struct EpiRes {
    static constexpr bool PERM = true, AFTER_DRAIN = false;
    const float* inP; const float* inS; float* out; float alpha, scale;
    __device__ __forceinline__ void operator()(const f32x4 (&acc)[2][2][4][2], const pg8::Unit& u, int wr, int wc, int fr, int fq) const {
        const int col = u.pn * 256 + wc * 32 + 8 * fq;
        EPI_ROWS_BEGIN
            if (r < MREAL) {
                const float* ip = (r < MPROMPT ? inP + (size_t)r * D : inS + (size_t)(r - MPROMPT) * D) + col; float* op = out + (size_t)r * D + col;
#pragma unroll
                for (int bj = 0; bj < 2; ++bj)
#pragma unroll
                    for (int n = 0; n < 2; ++n) { const f32x4 x = *(const f32x4*)(ip + bj * 128 + 4 * n); *(f32x4*)(op + bj * 128 + 4 * n) = x * alpha + acc[ai][bj][m][n] * scale; }
            }
        EPI_ROWS_END
    }
};
struct EpiQKV {
    static constexpr bool PERM = true, AFTER_DRAIN = false;
    bf16* Q; bf16* halo; float* sp_qkv; float* ss_qkv;
    __device__ __forceinline__ void operator()(const f32x4 (&acc)[2][2][4][2], const pg8::Unit& u, int wr, int wc, int fr, int fq) const {
        const int colt = u.pn * 256, t = colt >> 10, cb = (colt & 1023) + wc * 32 + 8 * fq, gcol = colt + wc * 32 + 8 * fq;
        bf16* base = Q + (size_t)t * UEL;
        EPI_ROWS_BEGIN
#pragma unroll
            for (int bj = 0; bj < 2; ++bj) {
                const f32x4 a0 = acc[ai][bj][m][0], a1 = acc[ai][bj][m][1]; const u32x4 w = pack44(a0, a1);
                *(u32x4*)(base + (size_t)r * D + cb + bj * 128) = w;
                if (r < MPROMPT) { const int tt = r & 63;
                    if (tt >= 61) { *(u32x4*)(halo + ((size_t)(r >> 6) * 3 + (tt - 61)) * 3072 + gcol + bj * 128) = w;
                        if (((r >> 6) & 31) == 31) { float* o = sp_qkv + ((size_t)(r >> 11) * 3 + (tt - 61)) * 3072 + gcol + bj * 128; *(f32x4*)o = a0; *(f32x4*)(o + 4) = a1; } }
                } else if (r < MREAL) { float* o = ss_qkv + ((size_t)(r - MPROMPT) * 3 + 2) * 3072 + gcol + bj * 128; *(f32x4*)o = a0; *(f32x4*)(o + 4) = a1; }
            }
        EPI_ROWS_END
    }
};
struct EpiB {
    static constexpr bool PERM = true, AFTER_DRAIN = false;
    bf16* R0; const float* ssq; const float* w_onorm; float* sp_sc; float* ss_sc;
    __device__ __forceinline__ void operator()(const f32x4 (&acc)[2][2][4][2], const pg8::Unit& u, int wr, int wc, int fr, int fq) const {
        const int pn = u.pn, cw = wc * 32 + 8 * fq; bf16* const O = R0 + 2 * UEL; bf16* const CH = R0;
        if (pn < 4) {
            EPI_ROWS_BEGIN
#pragma unroll
                for (int bj = 0; bj < 2; ++bj) { const int head = 2 * pn + bj, c = pn * 256 + bj * 128 + cw;
                    const float* sp = ssq + ((size_t)r * 8 + head) * 8; const f32x4 s0 = *(const f32x4*)sp, s1 = *(const f32x4*)(sp + 4);
                    const float rstd = __builtin_amdgcn_rsqf(((s0[0] + s0[1]) + (s0[2] + s0[3]) + (s1[0] + s1[1]) + (s1[2] + s1[3])) * (1.f / 128.f) + 1e-6f);
                    const u32x4 ow = *(const u32x4*)(O + (size_t)r * D + c);
                    const f32x4 w0 = *(const f32x4*)(w_onorm + cw), w1 = *(const f32x4*)(w_onorm + cw + 4);
                    const f32x4 g0 = lo4(ow) * w0 * silu4(acc[ai][bj][m][0]) * rstd, g1 = hi4(ow) * w1 * silu4(acc[ai][bj][m][1]) * rstd;
                    *(u32x4*)(O + (size_t)r * D + c) = pack44(g0, g1); }
            EPI_ROWS_END
        } else if (pn < 12) {
            const int c = (pn - 4) * 128 + cw;
            EPI_ROWS_BEGIN
                const f32x4 h0 = acc[ai][0][m][0] * acc[ai][1][m][0], h1 = acc[ai][0][m][1] * acc[ai][1][m][1];
                *(u32x4*)(CH + (size_t)r * D + c) = pack44(h0, h1);
                if (r < MPROMPT) { const int tt = r & 2047; if (tt >= 2046) { float* o = sp_sc + ((size_t)(r >> 11) * 2 + (tt - 2046)) * 1024 + c; *(f32x4*)o = h0; *(f32x4*)(o + 4) = h1; } }
                else if (r < MREAL) { float* o = ss_sc + ((size_t)(r - MPROMPT) * 2 + 1) * 1024 + c; *(f32x4*)o = h0; *(f32x4*)(o + 4) = h1; }
            EPI_ROWS_END
        } else {
            const int kind = (pn - 12) >> 2; bf16* dst = R0 + (size_t)(kind == 0 ? 1 : kind + 2) * UEL; const int c0 = ((pn - 12) & 3) * 256 + cw;
            EPI_ROWS_BEGIN
#pragma unroll
                for (int bj = 0; bj < 2; ++bj) { f32x4 a0 = acc[ai][bj][m][0], a1 = acc[ai][bj][m][1]; if (kind) { a0 = sigm4(a0); a1 = sigm4(a1); }
                    *(u32x4*)(dst + (size_t)r * D + c0 + bj * 128) = pack44(a0, a1); }
            EPI_ROWS_END
        }
    }
};
struct EpiMul {
    static constexpr bool PERM = true, AFTER_DRAIN = false;
    bf16* G;
    __device__ __forceinline__ void operator()(const f32x4 (&acc)[2][2][4][2], const pg8::Unit& u, int wr, int wc, int fr, int fq) const {
        const int col = u.pn * 256 + wc * 32 + 8 * fq;
        EPI_ROWS_BEGIN
#pragma unroll
            for (int bj = 0; bj < 2; ++bj) { bf16* p = G + (size_t)r * D + col + bj * 128; const u32x4 g = *(const u32x4*)p;
                *(u32x4*)p = pack44(lo4(g) * acc[ai][bj][m][0], hi4(g) * acc[ai][bj][m][1]); }
        EPI_ROWS_END
    }
};
struct EpiMerge {
    static constexpr bool PERM = true, AFTER_DRAIN = false;
    const bf16* M1; bf16* S;
    __device__ __forceinline__ void operator()(const f32x4 (&acc)[2][2][4][2], const pg8::Unit& u, int wr, int wc, int fr, int fq) const {
        const int col = u.pn * 256 + wc * 32 + 8 * fq;
        EPI_ROWS_BEGIN
#pragma unroll
            for (int bj = 0; bj < 2; ++bj) { const size_t off = (size_t)r * D + col + bj * 128; const u32x4 g = *(const u32x4*)(S + off), m1 = *(const u32x4*)(M1 + off);
                *(u32x4*)(S + off) = pack44(lo4(m1) + lo4(g) * acc[ai][bj][m][0], hi4(m1) + hi4(g) * acc[ai][bj][m][1]); }
        EPI_ROWS_END
    }
};
struct EpiStore {
    static constexpr bool PERM = true, AFTER_DRAIN = false;
    bf16* P;
    __device__ __forceinline__ void operator()(const f32x4 (&acc)[2][2][4][2], const pg8::Unit& u, int wr, int wc, int fr, int fq) const {
        const int col = u.pn * 256 + wc * 32 + 8 * fq;
        EPI_ROWS_BEGIN
#pragma unroll
            for (int bj = 0; bj < 2; ++bj) *(u32x4*)(P + (size_t)r * D + col + bj * 128) = pack44(acc[ai][bj][m][0], acc[ai][bj][m][1]);
        EPI_ROWS_END
    }
};
struct EpiPle {
    static constexpr bool PERM = true, AFTER_DRAIN = false;
    float* RES; const bf16* PP;
    __device__ __forceinline__ void operator()(const f32x4 (&acc)[2][2][4][2], const pg8::Unit& u, int wr, int wc, int fr, int fq) const {
        const int col = u.pn * 256 + wc * 32 + 8 * fq;
        EPI_ROWS_BEGIN
            if (r < MREAL) {
#pragma unroll
                for (int bj = 0; bj < 2; ++bj) { const size_t off = (size_t)r * D + col + bj * 128; const u32x4 pp = *(const u32x4*)(PP + off);
                    const f32x4 x0 = *(const f32x4*)(RES + off), x1 = *(const f32x4*)(RES + off + 4);
                    *(f32x4*)(RES + off) = x0 * ALPHA + sigm4(acc[ai][bj][m][0]) * lo4(pp); *(f32x4*)(RES + off + 4) = x1 * ALPHA + sigm4(acc[ai][bj][m][1]) * hi4(pp); }
            }
        EPI_ROWS_END
    }
};

__device__ __forceinline__ void xpose_item(const float* W, int ldw, int c0, int K, int ncols, bf16* WT, int d0, int mode, int sel, LAS float* scr, int item, int lane) {
    const int nblk = ncols >> 5, kb = item / nblk, nb = item - kb * nblk, k0 = 64 * kb, n0 = 32 * nb;
    const int drow = mode ? d0 + 256 * (n0 >> 7) + 128 * sel + (n0 & 127) : d0 + n0;
#pragma unroll 8
    for (int i = 0; i < 32; ++i) { const int kk = 2 * i + (lane >> 5); scr[kk * 33 + (lane & 31)] = W[(size_t)(k0 + kk) * ldw + c0 + n0 + (lane & 31)]; }
    asm volatile("s_waitcnt lgkmcnt(0)" ::: "memory");
    const int c = lane & 7;
#pragma unroll
    for (int j = 0; j < 4; ++j) { const int n = (lane >> 3) + 8 * j; const LAS float* s = scr + (8 * c) * 33 + n;
        u32x4 o; o.x = cvt_pk_bf16(s[0 * 33], s[1 * 33]); o.y = cvt_pk_bf16(s[2 * 33], s[3 * 33]); o.z = cvt_pk_bf16(s[4 * 33], s[5 * 33]); o.w = cvt_pk_bf16(s[6 * 33], s[7 * 33]);
        *(u32x4*)(WT + (size_t)(drow + n) * K + k0 + 8 * c) = o; }
    asm volatile("s_waitcnt lgkmcnt(0)" ::: "memory");
}
#define XSEG(W, ldw, c0, K, ncols, WT, d0, mode, sel) { const int ni_ = ((K) / 64) * ((ncols) / 32); if (r_ < ni_) { xpose_item(W, ldw, c0, K, ncols, WT, d0, mode, sel, scr, r_, lane); continue; } r_ -= ni_; }

struct Args { const float* in[32]; float* out; unsigned char* ws; int ph_lo, ph_hi; };

template <bool WRITE_BF16, bool DO_BA>
__device__ __forceinline__ void ln_phase(float* RES, const float* g, const float* b, bf16* XB, const LAS float* wba, const float* A_log, const float* dt_bias, float* BETA, float* GG, int gw, int NGW, int lane) {
    f32x4 gv[4], bv[4];
#pragma unroll
    for (int j = 0; j < 4; ++j) { gv[j] = *((const f32x4*)g + 64 * j + lane); bv[j] = *((const f32x4*)b + 64 * j + lane); }
    for (int m = gw; m < MREAL; m += NGW) {
        f32x4* xr = (f32x4*)(RES + (size_t)m * D) + lane;
        f32x4 v[4]; float s = 0.f;
#pragma unroll
        for (int j = 0; j < 4; ++j) { v[j] = xr[64 * j]; s += (v[j][0] + v[j][1]) + (v[j][2] + v[j][3]); }
        const float mean = wave_sum(s) * (1.f / D); float s2 = 0.f;
#pragma unroll
        for (int j = 0; j < 4; ++j) { v[j] = v[j] - mean; s2 += (v[j][0] * v[j][0] + v[j][1] * v[j][1]) + (v[j][2] * v[j][2] + v[j][3] * v[j][3]); }
        const float rstd = 1.f / sqrtf(wave_sum(s2) * (1.f / D) + 1e-5f);
#pragma unroll
        for (int j = 0; j < 4; ++j) { v[j] = v[j] * rstd * gv[j] + bv[j]; xr[64 * j] = v[j]; }
        if (WRITE_BF16) {
            u32x2* o8 = (u32x2*)(XB + (size_t)m * D) + lane;
#pragma unroll
            for (int j = 0; j < 4; ++j) { u32x2 w; w.x = cvt_pk_bf16(v[j][0], v[j][1]); w.y = cvt_pk_bf16(v[j][2], v[j][3]); o8[64 * j] = w; }
        }
        if (DO_BA) {
            float mine = 0.f;
#pragma unroll
            for (int c = 0; c < 16; ++c) { float p = 0.f;
#pragma unroll
                for (int j = 0; j < 4; ++j) { const f32x4 w = *((const LAS f32x4*)(wba + c * 1024) + 64 * j + lane); p += (v[j][0] * w[0] + v[j][1] * w[1]) + (v[j][2] * w[2] + v[j][3] * w[3]); }
                p = wave_sum(p); if (lane == c) mine = p; }
            if (lane < 8) BETA[(size_t)m * 8 + lane] = sigm(mine);
            else if (lane < 16) { const int h = lane - 8; const float xx = mine + dt_bias[h]; const float sp = xx > 20.f ? xx : log1pf(expf(xx)); GG[(size_t)m * 8 + h] = -expf(A_log[h]) * sp; }
        }
    }
}

template <int W>
__device__ __forceinline__ void cvt_rows(const float* srcP, const float* srcS, bf16* dst, int gw, int NGW, int lane) {
    for (int m = gw; m < MP; m += NGW) {
        const float* src = m < MPROMPT ? srcP + (size_t)m * W : srcS + (size_t)(m - MPROMPT) * W;
#pragma unroll
        for (int j = 0; j < W / 256; ++j) { f32x4 v = (f32x4){0.f, 0.f, 0.f, 0.f}; if (m < MREAL) v = *((const f32x4*)src + 64 * j + lane);
            u32x2 w; w.x = cvt_pk_bf16(v[0], v[1]); w.y = cvt_pk_bf16(v[2], v[3]); *((u32x2*)(dst + (size_t)m * W) + 64 * j + lane) = w; }
    }
}

constexpr int PREP_HALF = 70144 + 256;
__device__ __forceinline__ void prep_unit(LAS unsigned char* lds, int uidx, bf16* Qg, bf16* Kg, bf16* Vg, bf16* KT, bf16* QK, const bf16* HALO, const float* wconv, const float* BETA, const float* GG, float* GC) {
    const int tid = threadIdx.x, hb = tid >> 8, tl = tid & 255, lane = tid & 63, wq = (tid >> 6) & 3;
    const int b = uidx >> 7, rem = uidx & 127, h = rem >> 4, cp = rem & 15, n = 2 * cp + hb;
    const int gcid = b * 32 + n, m0 = b * 2048 + n * 64;
    LAS unsigned char* L = lds + hb * PREP_HALF;
    LAS bf16* Qs = (LAS bf16*)L; LAS bf16* Ks = Qs + 64 * 136; LAS bf16* Vs = Ks + 64 * 136;
    LAS float* Af = (LAS float*)(L + 3 * 17408); LAS float* gcs = Af + 64 * 68; LAS float* betas = gcs + 64; LAS float* egcs = betas + 64;
#ifndef PREP_STEPS
#define PREP_STEPS 7
#endif
    if (PREP_STEPS & 1) {
        const int c8 = tl & 15, rg = tl >> 4, colh = h * 128 + 8 * c8;
#pragma unroll
        for (int mat = 0; mat < 3; ++mat) {
            const bf16* src = (mat == 0 ? Qg : (mat == 1 ? Kg : Vg));
            float xin[7][8];
#pragma unroll
            for (int i = 0; i < 7; ++i) { const int rr = 4 * rg - 3 + i; u32x4 w = (u32x4){0u, 0u, 0u, 0u};
                if (rr >= 0) w = *(const u32x4*)(src + (size_t)(m0 + rr) * D + colh);
                else if (n > 0) w = *(const u32x4*)(HALO + ((size_t)(gcid - 1) * 3 + (3 + rr)) * 3072 + mat * 1024 + colh);
                unpack8(w, xin[i]); }
            float y[4][8];
#pragma unroll
            for (int r = 0; r < 4; ++r)
#pragma unroll
                for (int e = 0; e < 8; ++e) y[r][e] = 0.f;
#pragma unroll
            for (int j = 0; j < 4; ++j) { const float* wp = wconv + (size_t)j * 3072 + mat * 1024 + colh; const f32x4 w0 = *(const f32x4*)wp, w1 = *(const f32x4*)(wp + 4);
#pragma unroll
                for (int r = 0; r < 4; ++r) {
#pragma unroll
                    for (int e = 0; e < 4; ++e) { y[r][e] += w0[e] * xin[r + j][e]; y[r][4 + e] += w1[e] * xin[r + j][4 + e]; } } }
#pragma unroll
            for (int r = 0; r < 4; ++r) {
                float ss = 0.f;
#pragma unroll
                for (int e = 0; e < 8; ++e) { y[r][e] = silu(y[r][e]); ss += y[r][e] * y[r][e]; }
                if (mat < 2) { ss += __shfl_xor(ss, 1); ss += __shfl_xor(ss, 2); ss += __shfl_xor(ss, 4); ss += __shfl_xor(ss, 8);
                    const float rs = __builtin_amdgcn_rsqf(ss + 1e-6f) * (mat == 0 ? 0.08838834764831845f : 1.f);
#pragma unroll
                    for (int e = 0; e < 8; ++e) y[r][e] *= rs; }
                LAS bf16* dstl = (mat == 0 ? Qs : (mat == 1 ? Ks : Vs)) + (4 * rg + r) * 136 + 8 * c8;
                *(LAS u32x4*)dstl = pack8(y[r]);
            }
        }
        if (tl < 64) { const size_t gi = (size_t)(m0 + tl) * 8 + h; const float be = BETA[gi]; float gsum = GG[gi];
#pragma unroll
            for (int d = 1; d < 64; d <<= 1) { const float t = __shfl_up(gsum, d); if (lane >= d) gsum += t; }
            gcs[tl] = gsum; betas[tl] = be; egcs[tl] = be * __expf(gsum); GC[gi] = gsum; }
    }
    __syncthreads();
    if (PREP_STEPS & 2) {
        const int c8 = tl & 15, rg = tl >> 4, colh = h * 128 + 8 * c8;
#pragma unroll
        for (int r = 0; r < 4; ++r) *(u32x4*)(Qg + (size_t)(m0 + 4 * rg + r) * D + colh) = *(const LAS u32x4*)(Qs + (4 * rg + r) * 136 + 8 * c8);
        { const int dk = tl & 127, rh = tl >> 7; bf16* dst = KT + ((size_t)(gcid * 8 + h) * 128 + dk) * 64 + 32 * rh;
#pragma unroll
            for (int q4 = 0; q4 < 4; ++q4) { u32x4 w; unsigned t0[4];
#pragma unroll
                for (int e = 0; e < 4; ++e) { const int i = 32 * rh + 8 * q4 + 2 * e; t0[e] = (unsigned)Ks[i * 136 + dk] | ((unsigned)Ks[(i + 1) * 136 + dk] << 16); }
                w.x = t0[0]; w.y = t0[1]; w.z = t0[2]; w.w = t0[3]; *(u32x4*)(dst + 8 * q4) = w; } }
        const int ti = wq, li = lane & 15, lq = lane >> 4;
        f32x4 accA[4], accQ[4];
#pragma unroll
        for (int tj = 0; tj < 4; ++tj) { accA[tj] = (f32x4){0.f, 0.f, 0.f, 0.f}; accQ[tj] = (f32x4){0.f, 0.f, 0.f, 0.f}; }
#pragma unroll
        for (int ks = 0; ks < 4; ++ks) {
            const bf16x8 aK = *(const LAS bf16x8*)(Ks + (16 * ti + li) * 136 + 32 * ks + 8 * lq), aQ = *(const LAS bf16x8*)(Qs + (16 * ti + li) * 136 + 32 * ks + 8 * lq);
#pragma unroll
            for (int tj = 0; tj < 4; ++tj) { const bf16x8 bK = *(const LAS bf16x8*)(Ks + (16 * tj + li) * 136 + 32 * ks + 8 * lq);
                accA[tj] = __builtin_amdgcn_mfma_f32_16x16x32_bf16(aK, bK, accA[tj], 0, 0, 0); accQ[tj] = __builtin_amdgcn_mfma_f32_16x16x32_bf16(aQ, bK, accQ[tj], 0, 0, 0); }
        }
        bf16* qkg = QK + (size_t)(gcid * 8 + h) * 4096;
#pragma unroll
        for (int tj = 0; tj < 4; ++tj)
#pragma unroll
            for (int r = 0; r < 4; ++r) { const int i = 16 * ti + 4 * lq + r, j = 16 * tj + li;
                const float dec = (i >= j) ? __expf(gcs[i] - gcs[j]) : 0.f;
                Af[j * 68 + i] = (i > j) ? betas[i] * dec * accA[tj][r] : 0.f;
                qkg[i * 64 + j] = f2bf(dec * accQ[tj][r]); }
    }
    __syncthreads();
    if (PREP_STEPS & 4) {
        const int c = tl & 127, which = tl >> 7;
        LAS bf16* src = which ? Ks : Vs;
        const LAS float* scp = which ? egcs : betas;
        bf16* dst = (which ? Kg : Vg) + (size_t)m0 * D + h * 128 + c;
#pragma unroll 1
        for (int I = 0; I < 4; ++I) {
            float acc[16];
#pragma unroll
            for (int r = 0; r < 16; ++r) acc[r] = bf2f(src[(16 * I + r) * 136 + c]) * scp[16 * I + r];
#pragma unroll 2
            for (int j = 0; j < 16 * I; ++j) {
                const float xj = bf2f(src[j * 136 + c]);
                const LAS f32x4* ap = (const LAS f32x4*)(Af + j * 68 + 16 * I);
                const f32x4 a0 = ap[0], a1 = ap[1], a2 = ap[2], a3 = ap[3];
#pragma unroll
                for (int e = 0; e < 4; ++e) { acc[e] -= a0[e] * xj; acc[4 + e] -= a1[e] * xj; acc[8 + e] -= a2[e] * xj; acc[12 + e] -= a3[e] * xj; }
            }
#pragma unroll
            for (int q = 0; q < 15; ++q) {
                const float xq = acc[q];
                const LAS f32x4* ap = (const LAS f32x4*)(Af + (16 * I + q) * 68 + 16 * I);
#pragma unroll
                for (int g4 = (q + 1) / 4; g4 < 4; ++g4) { const f32x4 av = ap[g4];
#pragma unroll
                    for (int e = 0; e < 4; ++e) if (4 * g4 + e > q) acc[4 * g4 + e] -= av[e] * xq; }
            }
#pragma unroll
            for (int r = 0; r < 16; ++r) { const unsigned short xb = f2bf(acc[r]); src[(16 * I + r) * 136 + c] = xb; dst[(size_t)(16 * I + r) * D] = xb; }
        }
    }
    __syncthreads();
}

__device__ __forceinline__ void prep_sample(const float* st_qkv, float* ss_qkv, const float* wconv, float* SQKV, int G) {
    const int tid = threadIdx.x, c8 = tid & 15;
    for (int g = blockIdx.x * 32 + (tid >> 4); g < 128 * 24; g += G * 32) {
        const int bs = g / 24, mh = g - bs * 24, mat = mh >> 3, gcol = mh * 128 + 8 * c8;
        float y[8];
#pragma unroll
        for (int e = 0; e < 8; ++e) y[e] = 0.f;
#pragma unroll
        for (int j = 0; j < 4; ++j) {
            const float* xp = (j < 3) ? st_qkv + ((size_t)bs * 3 + j) * 3072 + gcol : ss_qkv + ((size_t)bs * 3 + 2) * 3072 + gcol;
            const f32x4 x0 = *(const f32x4*)xp, x1 = *(const f32x4*)(xp + 4);
            const float* wp = wconv + (size_t)j * 3072 + gcol; const f32x4 w0 = *(const f32x4*)wp, w1 = *(const f32x4*)(wp + 4);
#pragma unroll
            for (int e = 0; e < 4; ++e) { y[e] += w0[e] * x0[e]; y[4 + e] += w1[e] * x1[e]; }
            if (j >= 1 && j < 3) { float* o = ss_qkv + ((size_t)bs * 3 + (j - 1)) * 3072 + gcol; *(f32x4*)o = x0; *(f32x4*)(o + 4) = x1; }
        }
        float ss = 0.f;
#pragma unroll
        for (int e = 0; e < 8; ++e) { y[e] = silu(y[e]); ss += y[e] * y[e]; }
        if (mat < 2) { ss += __shfl_xor(ss, 1); ss += __shfl_xor(ss, 2); ss += __shfl_xor(ss, 4); ss += __shfl_xor(ss, 8);
            const float rs = __builtin_amdgcn_rsqf(ss + 1e-6f) * (mat == 0 ? 0.08838834764831845f : 1.f);
#pragma unroll
            for (int e = 0; e < 8; ++e) y[e] *= rs; }
        float* o = SQKV + (size_t)bs * 3072 + gcol; *(f32x4*)o = (f32x4){y[0], y[1], y[2], y[3]}; *(f32x4*)(o + 4) = (f32x4){y[4], y[5], y[6], y[7]};
    }
}

__device__ __forceinline__ void scan_unit(LAS unsigned char* lds, int uidx, const bf16* Qg, const bf16* Kg, bf16* Vg, const bf16* KT, const bf16* QK, const float* GC, float* SSQ, float* sp_gdn) {
    const int tid = threadIdx.x, lane = tid & 63, s = __builtin_amdgcn_readfirstlane(tid >> 6);
    const int xc = uidx & 7, yy = uidx >> 3, slab = yy & 3, bh = xc * 8 + (yy >> 2), b = bh >> 3, h = bh & 7;
    LAS bf16* St = (LAS bf16*)lds; LAS bf16* Vt = St + 2 * 32 * 136; LAS bf16* Vts = Vt + 32 * 72;
    const int ti = s >> 1, c = s & 1, li = lane & 15, lq = lane >> 4;
    f32x4 S0 = (f32x4){0.f, 0.f, 0.f, 0.f}, S1 = S0;
    const int ucol = h * 128 + slab * 32 + 16 * c + li;
    for (int n = 0; n < 32; ++n) {
        const int gcid = b * 32 + n, m0 = b * 2048 + n * 64;
        bf16x8 wA[4], qA[4], qkA[2], kA[2];
        { const bf16* wrow = Kg + (size_t)(m0 + 16 * ti + li) * D + h * 128 + 8 * lq; const bf16* qrow = Qg + (size_t)(m0 + 16 * ti + li) * D + h * 128 + 8 * lq;
#pragma unroll
          for (int ks = 0; ks < 4; ++ks) { wA[ks] = *(const bf16x8*)(wrow + 32 * ks); qA[ks] = *(const bf16x8*)(qrow + 32 * ks); }
          const bf16* qkrow = QK + ((size_t)(gcid * 8 + h) * 64 + 16 * ti + li) * 64 + 8 * lq; const bf16* ktrow = KT + ((size_t)(gcid * 8 + h) * 128 + 16 * s + li) * 64 + 8 * lq;
#pragma unroll
          for (int k2 = 0; k2 < 2; ++k2) { qkA[k2] = *(const bf16x8*)(qkrow + 32 * k2); kA[k2] = *(const bf16x8*)(ktrow + 32 * k2); } }
        float uval[4], gcr[4]; const int rowb = m0 + 16 * ti + 4 * lq;
#pragma unroll
        for (int r = 0; r < 4; ++r) { uval[r] = bf2f(Vg[(size_t)(rowb + r) * D + ucol]); gcr[r] = GC[(size_t)(rowb + r) * 8 + h]; }
        const float gl = GC[(size_t)(m0 + 63) * 8 + h];
        LAS bf16* Sb = St + (n & 1) * 32 * 136;
        { u32x2 w; w.x = cvt_pk_bf16(S0[0], S0[1]); w.y = cvt_pk_bf16(S0[2], S0[3]); *(LAS u32x2*)(Sb + li * 136 + 16 * s + 4 * lq) = w;
          w.x = cvt_pk_bf16(S1[0], S1[1]); w.y = cvt_pk_bf16(S1[2], S1[3]); *(LAS u32x2*)(Sb + (16 + li) * 136 + 16 * s + 4 * lq) = w; }
        __syncthreads();
        bf16x8 bS[4]; f32x4 acc = (f32x4){0.f, 0.f, 0.f, 0.f};
#pragma unroll
        for (int ks = 0; ks < 4; ++ks) { bS[ks] = *(const LAS bf16x8*)(Sb + (16 * c + li) * 136 + 32 * ks + 8 * lq); acc = __builtin_amdgcn_mfma_f32_16x16x32_bf16(wA[ks], bS[ks], acc, 0, 0, 0); }
        { float vn[4], vs[4];
#pragma unroll
          for (int r = 0; r < 4; ++r) { vn[r] = uval[r] - acc[r]; vs[r] = vn[r] * __expf(gl - gcr[r]); }
          u32x2 w; w.x = cvt_pk_bf16(vn[0], vn[1]); w.y = cvt_pk_bf16(vn[2], vn[3]); *(LAS u32x2*)(Vt + (16 * c + li) * 72 + 16 * ti + 4 * lq) = w;
          w.x = cvt_pk_bf16(vs[0], vs[1]); w.y = cvt_pk_bf16(vs[2], vs[3]); *(LAS u32x2*)(Vts + (16 * c + li) * 72 + 16 * ti + 4 * lq) = w; }
        __syncthreads();
        f32x4 o = (f32x4){0.f, 0.f, 0.f, 0.f};
#pragma unroll
        for (int ks = 0; ks < 4; ++ks) o = __builtin_amdgcn_mfma_f32_16x16x32_bf16(qA[ks], bS[ks], o, 0, 0, 0);
#pragma unroll
        for (int r = 0; r < 4; ++r) o[r] *= __expf(gcr[r]);
#pragma unroll
        for (int k2 = 0; k2 < 2; ++k2) { const bf16x8 bV = *(const LAS bf16x8*)(Vt + (16 * c + li) * 72 + 32 * k2 + 8 * lq); o = __builtin_amdgcn_mfma_f32_16x16x32_bf16(qkA[k2], bV, o, 0, 0, 0); }
#pragma unroll
        for (int r = 0; r < 4; ++r) { Vg[(size_t)(rowb + r) * D + ucol] = f2bf(o[r]); float sq = o[r] * o[r];
            sq += __shfl_xor(sq, 1); sq += __shfl_xor(sq, 2); sq += __shfl_xor(sq, 4); sq += __shfl_xor(sq, 8);
            if (li == 0) SSQ[((size_t)(rowb + r) * 8 + h) * 8 + slab * 2 + c] = sq; }
        const float eg = __expf(gl); S0 = S0 * eg; S1 = S1 * eg;
#pragma unroll
        for (int k2 = 0; k2 < 2; ++k2) { const bf16x8 b0 = *(const LAS bf16x8*)(Vts + li * 72 + 32 * k2 + 8 * lq), b1 = *(const LAS bf16x8*)(Vts + (16 + li) * 72 + 32 * k2 + 8 * lq);
            S0 = __builtin_amdgcn_mfma_f32_16x16x32_bf16(kA[k2], b0, S0, 0, 0, 0); S1 = __builtin_amdgcn_mfma_f32_16x16x32_bf16(kA[k2], b1, S1, 0, 0, 0); }
    }
    float* so = sp_gdn + ((size_t)(b * 8 + h) * 128 + 16 * s + 4 * lq) * 128 + slab * 32 + li;
#pragma unroll
    for (int r = 0; r < 4; ++r) { so[(size_t)r * 128] = S0[r]; so[(size_t)r * 128 + 16] = S1[r]; }
    __syncthreads();
}

__device__ __forceinline__ void gdn_sample_unit(LAS unsigned char* lds, int su, const float* state, float* ss_gdn, const float* SQKV, const float* BETA, const float* GG, bf16* Vg, float* SSQ) {
    const int tid = threadIdx.x, bs = su >> 3, h = su & 7, kq = tid >> 5, vq = tid & 31, m = MPROMPT + bs;
    const float* Sin = state + (size_t)su * 16384; float* Sout = ss_gdn + (size_t)su * 16384;
    f32x4 Sv[8];
#pragma unroll
    for (int i = 0; i < 8; ++i) Sv[i] = *(const f32x4*)(Sin + (size_t)(8 * kq + i) * 128 + 4 * vq);
    const float* qv = SQKV + (size_t)bs * 3072 + h * 128; const float* kv = qv + 1024; const float* vv = qv + 2048;
    float kk[8], qq[8];
#pragma unroll
    for (int i = 0; i < 8; ++i) { kk[i] = kv[8 * kq + i]; qq[i] = qv[8 * kq + i]; }
    const float a = expf(GG[(size_t)m * 8 + h]), be = BETA[(size_t)m * 8 + h];
    f32x4 p = (f32x4){0.f, 0.f, 0.f, 0.f};
#pragma unroll
    for (int i = 0; i < 8; ++i) { Sv[i] = Sv[i] * a; p += Sv[i] * kk[i]; }
    LAS f32x4* red = (LAS f32x4*)lds;
    red[kq * 32 + vq] = p; __syncthreads();
    f32x4 kvs = (f32x4){0.f, 0.f, 0.f, 0.f};
#pragma unroll
    for (int g = 0; g < 16; ++g) kvs += red[g * 32 + vq];
    const f32x4 dd = (*(const f32x4*)(vv + 4 * vq) - kvs) * be;
    f32x4 po = (f32x4){0.f, 0.f, 0.f, 0.f};
#pragma unroll
    for (int i = 0; i < 8; ++i) { Sv[i] += dd * kk[i]; po += Sv[i] * qq[i]; *(f32x4*)(Sout + (size_t)(8 * kq + i) * 128 + 4 * vq) = Sv[i]; }
    __syncthreads();
    red[kq * 32 + vq] = po; __syncthreads();
    if (tid < 64) {
        float ssum = 0.f;
        if (tid < 32) { f32x4 o = (f32x4){0.f, 0.f, 0.f, 0.f};
#pragma unroll
            for (int g = 0; g < 16; ++g) o += red[g * 32 + tid];
            u32x2 w; w.x = cvt_pk_bf16(o[0], o[1]); w.y = cvt_pk_bf16(o[2], o[3]); *(u32x2*)(Vg + (size_t)m * D + h * 128 + 4 * tid) = w;
            ssum = (o[0] * o[0] + o[1] * o[1]) + (o[2] * o[2] + o[3] * o[3]); }
        ssum = wave_sum(ssum);
        if (tid < 8) SSQ[((size_t)m * 8 + h) * 8 + tid] = tid == 0 ? ssum : 0.f;
    }
    __syncthreads();
}

__device__ __forceinline__ void conv3_phase(const bf16* CH, bf16* Bg, const float* wsc, const float* st_sc, float* ss_sc, int G) {
    const size_t total = (size_t)MREAL * 128;
    for (size_t it = (size_t)blockIdx.x * 512 + threadIdx.x; it < total; it += (size_t)G * 512) {
        const int m = (int)(it >> 7), c = (int)(it & 127) * 8;
        float x0[8], x1[8], x2[8], bg[8], w0[8], w1[8], w2[8];
        unpack8(*(const u32x4*)(CH + (size_t)m * D + c), x2); unpack8(*(const u32x4*)(Bg + (size_t)m * D + c), bg);
#pragma unroll
        for (int e = 0; e < 8; ++e) { w0[e] = wsc[c + e]; w1[e] = wsc[1024 + c + e]; w2[e] = wsc[2048 + c + e]; x0[e] = 0.f; x1[e] = 0.f; }
        if (m < MPROMPT) { const int t = m & 2047;
            if (t >= 1) unpack8(*(const u32x4*)(CH + (size_t)(m - 1) * D + c), x1);
            if (t >= 2) unpack8(*(const u32x4*)(CH + (size_t)(m - 2) * D + c), x0);
        } else { const int bs = m - MPROMPT; const float* s0 = st_sc + ((size_t)bs * 2) * 1024 + c; float* o = ss_sc + ((size_t)bs * 2) * 1024 + c;
#pragma unroll
            for (int e = 0; e < 8; ++e) { x0[e] = s0[e]; x1[e] = s0[1024 + e]; o[e] = s0[1024 + e]; } }
        float y[8];
#pragma unroll
        for (int e = 0; e < 8; ++e) y[e] = bg[e] * (w0[e] * x0[e] + w1[e] * x1[e] + w2[e] * x2[e]);
        *(u32x4*)(Bg + (size_t)m * D + c) = pack8(y);
    }
}

__device__ __forceinline__ unsigned long long arg_q(int k) { const __attribute__((address_space(4))) unsigned long long* b = (const __attribute__((address_space(4))) unsigned long long*)__builtin_amdgcn_kernarg_segment_ptr(); asm volatile("" : "+s"(b)); return b[k]; }
__device__ __forceinline__ const float* arg_in(int k) { return (const float*)arg_q(k); }
__global__ void __launch_bounds__(NWAVES * 64, 2) mega_fwd(Args args) {
    extern __shared__ __attribute__((aligned(16))) unsigned char lds_raw[];
    LAS unsigned char* lds = (LAS unsigned char*)lds_raw;
    cg::grid_group grid = cg::this_grid();
    const int tid = threadIdx.x, lane = tid & 63, wave = __builtin_amdgcn_readfirstlane(tid >> 6);
    const int G = gridDim.x, gw = blockIdx.x * NWAVES + wave, NGW = G * NWAVES;
#define ws  ((unsigned char*)arg_q(33))
#define out ((float*)arg_q(32))
#define WGU ((bf16*)(ws + WS_WGU))
#define WD ((bf16*)(ws + WS_WD))
#define WQKV ((bf16*)(ws + WS_WQKV))
#define WINB ((bf16*)(ws + WS_WINB))
#define WPG ((bf16*)(ws + WS_WPG))
#define WPS ((bf16*)(ws + WS_WPS))
#define WO ((bf16*)(ws + WS_WO))
#define WPLEG ((bf16*)(ws + WS_WPLEG))
#define WPLEP ((bf16*)(ws + WS_WPLEP))
#define WBA ((float*)(ws + WS_WBA))
#define XB ((bf16*)(ws + WS_XB))
#define R0 ((bf16*)(ws + WS_R))
#define R1 (R0 + UEL)
#define R2 (R0 + 2 * UEL)
#define R3 (R0 + 3 * UEL)
#define R4 (R0 + 4 * UEL)
#define BETA ((float*)(ws + WS_BETA))
#define GG ((float*)(ws + WS_GG))
#define GC ((float*)(ws + WS_GC))
#define SSQ ((float*)(ws + WS_SSQ))
#define HALO ((bf16*)(ws + WS_HALO))
#define SQKV ((float*)(ws + WS_SQKV))
#define RES out
    const int lo = args.ph_lo, hi = args.ph_hi;
#ifndef PH_MASK
#define PH_MASK 0x7ffff
#endif
#define IN(k) (((PH_MASK >> (k)) & 1) && lo <= (k) && (k) < hi)
#define SEAM(k) do { if (IN(k) && IN((k) + 1)) { asm volatile("s_waitcnt vmcnt(0) lgkmcnt(0)" ::: "memory"); __syncthreads(); grid.sync(); \
        __builtin_amdgcn_fence(__ATOMIC_ACQUIRE, "agent"); asm volatile("s_waitcnt vmcnt(0)" ::: "memory"); } } while (0)
#define GEMM(EpiT, E, Aop, Bop, N_, K_) do { int k_ = K_; asm volatile("" : "+s"(k_)); pg8::Gemm g_{Aop, Bop, MP, N_, k_}; pg8::StaticOrder S_; S_.init(MP, N_, G, (int)blockIdx.x); \
        pg8::gemm_phase<EpiT, pg8::StaticOrder, true, true>(lds, g_, S_, E); } while (0)

    if (IN(0)) {
        LAS float* scr = (LAS float*)(lds + wave * 16384);
        const float* w_in = arg_in(12);
        constexpr int NIT = 2 * (16 * 88) + 44 * 32 + 16 * 96 + 16 * 32 * 6 + 4 * 16 * 32 + 4 * 32;
        for (int it = gw; it < NIT; it += NGW) {
            int r_ = it;
            XSEG(arg_in(7), FF, 0, 1024, FF, WGU, 0, 1, 0)
            XSEG(arg_in(8), FF, 0, 1024, FF, WGU, 0, 1, 1)
            XSEG(arg_in(9), D, 0, FF, D, WD, 0, 0, 0)
            XSEG(w_in, INW, 0, 1024, 3072, WQKV, 0, 0, 0)
            XSEG(w_in, INW, 3072, 1024, 1024, WINB, 0, 0, 0)
            XSEG(w_in, INW, 5136, 1024, 1024, WINB, 1024, 1, 0)
            XSEG(w_in, INW, 6160, 1024, 1024, WINB, 1024, 1, 1)
            XSEG(w_in, INW, 4112, 1024, 1024, WINB, 3072, 0, 0)
            XSEG(w_in, INW, 7184, 1024, 1024, WINB, 4096, 0, 0)
            XSEG(w_in, INW, 8208, 1024, 1024, WINB, 5120, 0, 0)
            XSEG(arg_in(17), D, 0, 1024, 1024, WPG, 0, 0, 0)
            XSEG(arg_in(19), D, 0, 1024, 1024, WPS, 0, 0, 0)
            XSEG(arg_in(20), D, 0, 1024, 1024, WO, 0, 0, 0)
            XSEG(arg_in(28), D, 0, 1024, 1024, WPLEG, 0, 0, 0)
            XSEG(arg_in(29), D, 0, 256, 1024, WPLEP, 0, 0, 0)
        }
        for (int e = blockIdx.x * 512 + tid; e < 16 * 1024; e += G * 512) { const int c = e >> 10, k = e & 1023; WBA[e] = w_in[(size_t)k * INW + 4096 + c]; }
        cvt_rows<1024>(arg_in(0), arg_in(1), XB, gw, NGW, lane);
    }
    SEAM(0);
    if (IN(1)) { EpiGU E{R0}; GEMM(EpiGU, E, XB, WGU, 5632, 1024); }
    SEAM(1);
    if (IN(2)) { EpiRes E{arg_in(0), arg_in(1), RES, ALPHA, 0.5f}; GEMM(EpiRes, E, R0, WD, 1024, FF); }
    SEAM(2);
    if (IN(3)) {
        for (int e = tid; e < 16 * 1024 / 4; e += 512) ((LAS f32x4*)lds)[e] = ((const f32x4*)WBA)[e];
        __syncthreads();
        ln_phase<true, true>(RES, arg_in(10), arg_in(11), XB, (const LAS float*)lds, arg_in(14), arg_in(15), BETA, GG, gw, NGW, lane);
        __syncthreads();
    }
    SEAM(3);
    if (IN(4)) { EpiQKV E{R0, HALO, out + O_SPQ, out + O_SSQ}; GEMM(EpiQKV, E, XB, WQKV, 3072, 1024); }
    SEAM(4);
    if (IN(5)) {
        for (int u = blockIdx.x; u < 1024; u += G) prep_unit(lds, u, R0, R1, R2, R3, R4, HALO, arg_in(13), BETA, GG, GC);
        prep_sample(arg_in(5), out + O_SSQ, arg_in(13), SQKV, G);
    }
    SEAM(5);
    if (IN(6)) {
        for (int u = blockIdx.x; u < 256; u += G) scan_unit(lds, u, R0, R1, R2, R3, R4, GC, SSQ, out + O_SPG);
        for (int su = blockIdx.x; su < 1024; su += G) gdn_sample_unit(lds, su, arg_in(4), out + O_SSG, SQKV, BETA, GG, R2, SSQ);
    }
    SEAM(6);
    if (IN(7)) { EpiB E{R0, SSQ, arg_in(16), out + O_SPC, out + O_SSC}; GEMM(EpiB, E, XB, WINB, 6144, 1024); }
    SEAM(7);
    if (IN(8)) conv3_phase(R0, R1, arg_in(18), arg_in(6), out + O_SSC, G);
    SEAM(8);
    if (IN(9)) { EpiMul E{R3}; GEMM(EpiMul, E, R2, WPG, 1024, 1024); }
    SEAM(9);
    if (IN(10)) { EpiMerge E{R3, R4}; GEMM(EpiMerge, E, R1, WPS, 1024, 1024); }
    SEAM(10);
    if (IN(11)) { EpiRes E{RES, RES + (size_t)MPROMPT * D, RES, ALPHA, 1.0f}; GEMM(EpiRes, E, R4, WO, 1024, 1024); }
    SEAM(11);
    if (IN(12)) {
        ln_phase<true, false>(RES, arg_in(21), arg_in(22), XB, nullptr, nullptr, nullptr, nullptr, nullptr, gw, NGW, lane);
        LAS float* scr = (LAS float*)(lds + wave * 16384);
        constexpr int NIT = 2 * (16 * 88) + 44 * 32;
        for (int it = gw; it < NIT; it += NGW) {
            int r_ = it;
            XSEG(arg_in(23), FF, 0, 1024, FF, WGU, 0, 1, 0)
            XSEG(arg_in(24), FF, 0, 1024, FF, WGU, 0, 1, 1)
            XSEG(arg_in(25), D, 0, FF, D, WD, 0, 0, 0)
        }
    }
    SEAM(12);
    if (IN(13)) { EpiGU E{R0}; GEMM(EpiGU, E, XB, WGU, 5632, 1024); }
    SEAM(13);
    if (IN(14)) { EpiRes E{RES, RES + (size_t)MPROMPT * D, RES, ALPHA, 0.5f}; GEMM(EpiRes, E, R0, WD, 1024, FF); }
    SEAM(14);
    if (IN(15)) {
        ln_phase<true, false>(RES, arg_in(26), arg_in(27), XB, nullptr, nullptr, nullptr, nullptr, nullptr, gw, NGW, lane);
        cvt_rows<256>(arg_in(2), arg_in(3), R1, gw, NGW, lane);
    }
    SEAM(15);
    if (IN(16)) { EpiStore E{R0}; GEMM(EpiStore, E, R1, WPLEP, 1024, 256); }
    SEAM(16);
    if (IN(17)) { EpiPle E{RES, R0}; GEMM(EpiPle, E, XB, WPLEG, 1024, 1024); }
    SEAM(17);
    if (IN(18)) ln_phase<false, false>(RES, arg_in(30), arg_in(31), nullptr, nullptr, nullptr, nullptr, nullptr, nullptr, gw, NGW, lane);
#undef IN
#undef SEAM
#undef GEMM
}
#undef ws
#undef out
#undef WGU
#undef WD
#undef WQKV
#undef WINB
#undef WPG
#undef WPS
#undef WO
#undef WPLEG
#undef WPLEP
#undef WBA
#undef XB
#undef R0
#undef R1
#undef R2
#undef R3
#undef R4
#undef BETA
#undef GG
#undef GC
#undef SSQ
#undef HALO
#undef SQKV
#undef RES


constexpr int N_PHASES = 19;
#ifndef MK_SPLIT
#define MK_SPLIT 0
#endif

extern "C" void kernel_launch(void* const* d_in, const int* in_sizes, int n_in, void* d_out, int out_size, void* d_ws, size_t ws_size, hipStream_t stream) {
    static int grid = 0;
    if (grid == 0) {
        if (n_in != 32 || out_size != (int)O_END || ws_size < WS_END) {
            fprintf(stderr, "kernel_launch: unexpected sizes n_in %d out %d ws %zu (need %zu)\n", n_in, out_size, ws_size, (size_t)WS_END);
            grid = -1;
        } else {
            int dev = 0, cus = 0, per_cu = 0;
            hipGetDevice(&dev); hipDeviceGetAttribute(&cus, hipDeviceAttributeMultiprocessorCount, dev);
            hipFuncSetAttribute((const void*)mega_fwd, hipFuncAttributeMaxDynamicSharedMemorySize, LDS_BYTES);
            hipOccupancyMaxActiveBlocksPerMultiprocessor(&per_cu, (const void*)mega_fwd, NWAVES * 64, LDS_BYTES);
            if (per_cu < 1) { fprintf(stderr, "kernel_launch: occupancy query says %d blocks per CU\n", per_cu); grid = -1; }
            else grid = cus;
        }
    }
    if (grid < 0) { (void)hipMemsetAsync(d_out, 0xFF, (size_t)out_size * 4, stream); return; }
    Args a{};
    for (int i = 0; i < 32; ++i) a.in[i] = (const float*)d_in[i];
    a.out = (float*)d_out; a.ws = (unsigned char*)d_ws;
#if MK_SPLIT
    for (int p = 0; p < N_PHASES; ++p) { a.ph_lo = p; a.ph_hi = p + 1; hipLaunchKernelGGL(mega_fwd, dim3(grid), dim3(NWAVES * 64), LDS_BYTES, stream, a); }
#else
    a.ph_lo = 0; a.ph_hi = N_PHASES;
    void* kargs[] = {&a};
    hipError_t e = hipLaunchCooperativeKernel((const void*)mega_fwd, dim3(grid), dim3(NWAVES * 64), kargs, LDS_BYTES, stream);
    if (e != hipSuccess) fprintf(stderr, "cooperative launch failed: %s (grid %d)\n", hipGetErrorString(e), grid);
#endif
}
```

```cpp
#include <hip/hip_runtime.h>
#include <hip/hip_cooperative_groups.h>
#include <cstdio>
#include <cstdint>
namespace cg = cooperative_groups;
namespace pg8 {
#define PG8_LAS __attribute__((address_space(3)))
typedef unsigned short bf16_t;
typedef short bf16x8 __attribute__((ext_vector_type(8)));
typedef float f32x4 __attribute__((ext_vector_type(4)));
typedef unsigned u32x4 __attribute__((ext_vector_type(4)));
constexpr int BM = 256, BK = 64, HALF = 128, HTB = HALF * BK * 2  , STAGE_BYTES = 8 * HTB, NXCD = 8, WGM = 8;

__host__ __device__ __forceinline__ int lds_byte(int r, int c) { const int st = (r >> 4) * 2 + (c >> 5), rr = r & 15, cc = c & 31, ob = rr * 64 + cc * 2; return st * 1024 + (ob ^ (((ob >> 9) & 1) << 5)); }
__host__ __device__ __forceinline__ void stage_rc(int b, int& R, int& C) { const int st = b / 1024, sb = b % 1024, swz = sb ^ (((sb >> 9) & 1) << 5); R = (st >> 1) * 16 + swz / 64; C = (st & 1) * 32 + (swz % 64) / 2; }
__host__ __device__ __forceinline__ int perm32(int rho) { const int n = rho >> 4, i = rho & 15; return 8 * (i >> 2) + 4 * n + (i & 3); }

struct Unit { int pm, pn; };
struct Gemm { const bf16_t* A; const bf16_t* Bt; int M, N, K; };

struct StaticOrder {
    int nM, nN, nwg, G, c;
    __host__ __device__ void init(int M, int N, int G_, int c_) { nM = M / BM; nN = N / BM; nwg = nM * nN; G = G_; c = c_; }
    __host__ __device__ bool next(int i, Unit& u) const {
        const long L = (long)i * G + c; if (L >= nwg) return false;
        int wgid = (int)L; { const int q = nwg / NXCD, r = nwg % NXCD, xcd = wgid % NXCD, off = wgid / NXCD; wgid = (xcd < r ? xcd * (q + 1) : r * (q + 1) + (xcd - r) * q) + off; }
        const int nig = WGM * nN, gid = wgid / nig, fm = gid * WGM, gsz = (nM - fm) < WGM ? (nM - fm) : WGM;
        u.pm = fm + ((wgid % nig) % gsz); u.pn = (wgid % nig) / gsz; return true;
    }
    __device__ __forceinline__ void a_ready(const Unit&) const {}
    __device__ __forceinline__ void done(const Unit&) const {}
};

typedef __bf16 bf16x2n __attribute__((ext_vector_type(2)));
__device__ __forceinline__ unsigned cvt_pk_bf16(float lo, float hi) { bf16x2n v; v.x = (__bf16)lo; v.y = (__bf16)hi; return __builtin_bit_cast(unsigned, v); }
typedef float f32x2 __attribute__((ext_vector_type(2)));
template <class Epi, class Sched, bool ALIGN_EPI = false, bool SP2 = false>
__device__ __forceinline__ void gemm_phase(PG8_LAS unsigned char* lds, const Gemm g, const Sched& S, const Epi& E) {
    const int tid = threadIdx.x, wid = __builtin_amdgcn_readfirstlane(tid >> 6), lane = tid & 63, wr = wid >> 2, wc = wid & 3, fr = lane & 15, fq = lane >> 4;
    const int K = g.K, nt = K / BK;
    unsigned voffA[2], voffB[2];
#pragma unroll
    for (int i = 0; i < 2; ++i) { int R, C; stage_rc(tid * 16 + i * 8192, R, C); const int Rb = Epi::PERM ? ((R & ~31) + perm32(R & 31)) : R;
        voffA[i] = (unsigned)(R * K + C) * 2u; voffB[i] = (unsigned)(Rb * K + C) * 2u; }
    const size_t kstep = (size_t)(BK * 2);
    const size_t hstep = (size_t)HALF * K * 2;
    const size_t tstep = 2 * hstep;
    const unsigned ldsw = (unsigned)wid * 1024u;
    const int aoff = lds_byte(wr * 64 + fr, fq * 8), boff = lds_byte(wc * 32 + fr, fq * 8);
#define PG8_SA(b, h) (((b) * 2 + (h)) * HTB)
#define PG8_SB(b, h) ((4 + (b) * 2 + (h)) * HTB)
#define PG8_STAGE(bufoff, gbase, voff) do { _Pragma("unroll") for (int _i = 0; _i < 2; ++_i) \
        __builtin_amdgcn_global_load_lds((const unsigned*)((const char*)(gbase) + (voff)[_i]), (PG8_LAS unsigned*)(lds + (bufoff) + ldsw + _i * 8192), 16, 0, 0); } while (0)
#define PG8_LDA(dst, b, h) do { _Pragma("unroll") for (int m = 0; m < 4; ++m) _Pragma("unroll") for (int k = 0; k < 2; ++k) dst[m][k] = *(const PG8_LAS bf16x8*)(lds + PG8_SA(b, h) + aoff + m * 2048 + k * 1024); } while (0)
#define PG8_LDB(dst, b, h) do { _Pragma("unroll") for (int n = 0; n < 2; ++n) _Pragma("unroll") for (int k = 0; k < 2; ++k) dst[n][k] = *(const PG8_LAS bf16x8*)(lds + PG8_SB(b, h) + boff + n * 2048 + k * 1024); } while (0)
#define PG8_MMA(ai, bj, At, Bt) do { __builtin_amdgcn_s_setprio(1); _Pragma("unroll") for (int m = 0; m < 4; ++m) _Pragma("unroll") for (int n = 0; n < 2; ++n) _Pragma("unroll") for (int k = 0; k < 2; ++k) \
        acc[ai][bj][m][n] = __builtin_amdgcn_mfma_f32_16x16x32_bf16(Bt[n][k], At[m][k], acc[ai][bj][m][n], 0, 0, 0); __builtin_amdgcn_s_setprio(0); } while (0)
#define PG8_WAIT_V(n) asm volatile("s_waitcnt vmcnt(" #n ")" ::: "memory")
#define PG8_WAIT_L(n) asm volatile("s_waitcnt lgkmcnt(" #n ")" ::: "memory")
#define PG8_BAR __builtin_amdgcn_s_barrier()
#define PG8_SCHED __builtin_amdgcn_sched_barrier(0)
    Unit cur, nxt; int ui = 0;
    if (!S.next(0, cur)) return;
    f32x4 acc[2][2][4][2];
#pragma unroll
    for (int a = 0; a < 2; ++a)
#pragma unroll
        for (int b = 0; b < 2; ++b)
#pragma unroll
            for (int m = 0; m < 4; ++m)
#pragma unroll
                for (int n = 0; n < 2; ++n) acc[a][b][m][n] = (f32x4){0.f, 0.f, 0.f, 0.f};
    bf16x8 At[4][2], B0[2][2], B1[2][2];
    const char* cA = (const char*)g.A + (size_t)cur.pm * tstep; const char* cB = (const char*)g.Bt + (size_t)cur.pn * tstep;
    S.a_ready(cur);
    if constexpr (SP2) {
        PG8_STAGE(PG8_SB(0, 0), cB, voffB); PG8_STAGE(PG8_SB(0, 1), cB + hstep, voffB); PG8_STAGE(PG8_SA(0, 0), cA, voffA); PG8_STAGE(PG8_SA(0, 1), cA + hstep, voffA);
        if (wr == 1) PG8_BAR;
        PG8_WAIT_V(2); PG8_BAR;
        PG8_STAGE(PG8_SB(1, 0), cB + kstep, voffB); PG8_STAGE(PG8_SA(1, 0), cA + kstep, voffA); PG8_STAGE(PG8_SB(1, 1), cB + hstep + kstep, voffB);
        PG8_WAIT_V(6); PG8_BAR;
    } else {
        PG8_STAGE(PG8_SB(0, 0), cB, voffB); PG8_STAGE(PG8_SA(0, 0), cA, voffA); PG8_STAGE(PG8_SB(0, 1), cB + hstep, voffB); PG8_STAGE(PG8_SA(0, 1), cA + hstep, voffA);
        if (wr == 1) PG8_BAR;
        PG8_WAIT_V(4); PG8_BAR;
        PG8_STAGE(PG8_SB(1, 0), cB + kstep, voffB); PG8_STAGE(PG8_SA(1, 0), cA + kstep, voffA); PG8_STAGE(PG8_SB(1, 1), cB + hstep + kstep, voffB);
        PG8_WAIT_V(6); PG8_BAR;
    }
    for (;;) {
        const bool has_next = S.next(ui + 1, nxt);
        const char* nA = has_next ? (const char*)g.A + (size_t)nxt.pm * tstep : cA; const char* nB = has_next ? (const char*)g.Bt + (size_t)nxt.pn * tstep : cB;
        for (int t = 0; t < nt; t += 2) {
            const bool last = (t == nt - 2);
            const char* a1 = cA + (size_t)(t + 1) * kstep;
            const char* a2 = last ? nA : cA + (size_t)(t + 2) * kstep; const char* b2 = last ? nB : cB + (size_t)(t + 2) * kstep;
            const char* a3 = a2 + kstep; const char* b3 = b2 + kstep;
            if (last && has_next) S.a_ready(nxt);
            if constexpr (SP2) {
            PG8_LDB(B0, 0, 0); PG8_LDB(B1, 0, 1); PG8_SCHED; PG8_LDA(At, 0, 0); PG8_STAGE(PG8_SA(1, 1), a1 + hstep, voffA);
            PG8_WAIT_V(8); PG8_WAIT_L(0); PG8_BAR; PG8_MMA(0, 0, At, B0); PG8_MMA(0, 1, At, B1); PG8_BAR; PG8_SCHED;
            PG8_LDA(At, 0, 1); PG8_STAGE(PG8_SB(0, 0), b2, voffB); PG8_STAGE(PG8_SB(0, 1), b2 + hstep, voffB); PG8_STAGE(PG8_SA(0, 0), a2, voffA);
            PG8_WAIT_V(8); PG8_WAIT_L(0); PG8_BAR; PG8_MMA(1, 0, At, B0); PG8_MMA(1, 1, At, B1); PG8_BAR; PG8_SCHED;
            PG8_LDB(B0, 1, 0); PG8_LDB(B1, 1, 1); PG8_SCHED; PG8_LDA(At, 1, 0); PG8_STAGE(PG8_SA(0, 1), a2 + hstep, voffA);
            PG8_WAIT_V(8); PG8_WAIT_L(0); PG8_BAR; PG8_MMA(0, 0, At, B0); PG8_MMA(0, 1, At, B1); PG8_BAR; PG8_SCHED;
            PG8_LDA(At, 1, 1); PG8_STAGE(PG8_SB(1, 0), b3, voffB); PG8_STAGE(PG8_SB(1, 1), b3 + hstep, voffB); PG8_STAGE(PG8_SA(1, 0), a3, voffA);
            PG8_WAIT_V(8); PG8_WAIT_L(0); PG8_BAR; PG8_MMA(1, 0, At, B0); PG8_MMA(1, 1, At, B1); PG8_BAR; PG8_SCHED;
            } else {
            PG8_LDB(B0, 0, 0); PG8_SCHED; PG8_LDA(At, 0, 0); PG8_STAGE(PG8_SA(1, 1), a1 + hstep, voffA);
            PG8_WAIT_L(8); PG8_BAR; PG8_WAIT_L(0); PG8_MMA(0, 0, At, B0); PG8_BAR; PG8_SCHED;
            PG8_LDB(B1, 0, 1); PG8_STAGE(PG8_SB(0, 0), b2, voffB);
            PG8_BAR; PG8_WAIT_L(0); PG8_MMA(0, 1, At, B1); PG8_BAR;
            PG8_LDA(At, 0, 1); PG8_STAGE(PG8_SA(0, 0), a2, voffA);
            PG8_BAR; PG8_WAIT_L(0); PG8_MMA(1, 0, At, B0); PG8_BAR; PG8_SCHED;
            PG8_STAGE(PG8_SB(0, 1), b2 + hstep, voffB);
            PG8_WAIT_V(6); PG8_BAR; PG8_MMA(1, 1, At, B1); PG8_BAR;
            PG8_LDB(B0, 1, 0); PG8_SCHED; PG8_LDA(At, 1, 0); PG8_STAGE(PG8_SA(0, 1), a2 + hstep, voffA);
            PG8_WAIT_L(8); PG8_BAR; PG8_WAIT_L(0); PG8_MMA(0, 0, At, B0); PG8_BAR; PG8_SCHED;
            PG8_LDB(B1, 1, 1); PG8_STAGE(PG8_SB(1, 0), b3, voffB);
            PG8_BAR; PG8_WAIT_L(0); PG8_MMA(0, 1, At, B1); PG8_BAR;
            PG8_LDA(At, 1, 1); PG8_STAGE(PG8_SA(1, 0), a3, voffA);
            PG8_BAR; PG8_WAIT_L(0); PG8_MMA(1, 0, At, B0); PG8_BAR; PG8_SCHED;
            PG8_STAGE(PG8_SB(1, 1), b3 + hstep, voffB);
            PG8_WAIT_V(6); PG8_BAR; PG8_MMA(1, 1, At, B1); PG8_BAR;
            }
        }
        if constexpr (ALIGN_EPI) { if (wr == 0) PG8_BAR; }
        if constexpr (!Epi::AFTER_DRAIN) { E(acc, cur, wr, wc, fr, fq); S.done(cur); }
        if (!has_next) break;
#pragma unroll
        for (int a = 0; a < 2; ++a)
#pragma unroll
            for (int b = 0; b < 2; ++b)
#pragma unroll
                for (int m = 0; m < 4; ++m)
#pragma unroll
                    for (int n = 0; n < 2; ++n) acc[a][b][m][n] = (f32x4){0.f, 0.f, 0.f, 0.f};
        cur = nxt; cA = nA; cB = nB; ++ui;
        if constexpr (ALIGN_EPI) { if (wr == 1) PG8_BAR; }
    }
    PG8_WAIT_V(0);
    if constexpr (!ALIGN_EPI) { if (wr == 0) PG8_BAR; }
    PG8_BAR;
    if constexpr (Epi::AFTER_DRAIN) { E.fused(acc, cur, wr, wc, fr, fq, lds, wid, lane); S.done(cur); }
#undef PG8_SA
#undef PG8_SB
#undef PG8_STAGE
#undef PG8_LDA
#undef PG8_LDB
#undef PG8_MMA
#undef PG8_WAIT_V
#undef PG8_WAIT_L
#undef PG8_BAR
#undef PG8_SCHED
}
}

#define LAS __attribute__((address_space(3)))
typedef unsigned short bf16;
typedef pg8::f32x4 f32x4;
typedef pg8::u32x4 u32x4;
typedef pg8::bf16x8 bf16x8;
typedef unsigned u32x2 __attribute__((ext_vector_type(2)));
using pg8::cvt_pk_bf16;

constexpr int D = 1024, FF = 2816, MPROMPT = 16384, MS = 128, MREAL = MPROMPT + MS, MP = 16640;
constexpr int INW = 9232;
constexpr float ALPHA = 1.189207115002721f;
constexpr int NWAVES = 8;
constexpr int LDS_BYTES = 147456;

constexpr size_t UEL = (size_t)MP * 1024;
constexpr size_t UB = UEL * 2;
constexpr size_t WS_WGU = 16384;
constexpr size_t WS_WD = WS_WGU + (size_t)5632 * 1024 * 2;
constexpr size_t WS_WQKV = WS_WD + (size_t)1024 * 2816 * 2;
constexpr size_t WS_WINB = WS_WQKV + (size_t)3072 * 1024 * 2;
constexpr size_t WS_WPG = WS_WINB + (size_t)6144 * 1024 * 2;
constexpr size_t WS_WPS = WS_WPG + 2097152, WS_WO = WS_WPS + 2097152, WS_WPLEG = WS_WO + 2097152, WS_WPLEP = WS_WPLEG + 2097152;
constexpr size_t WS_WBA = WS_WPLEP + 524288;
constexpr size_t WS_XB = WS_WBA + 65536;
constexpr size_t WS_R = WS_XB + UB;
constexpr size_t WS_BETA = WS_R + 5 * UB;
constexpr size_t WS_GG = WS_BETA + (size_t)MP * 32, WS_GC = WS_GG + (size_t)MP * 32, WS_SSQ = WS_GC + (size_t)MP * 32;
constexpr size_t WS_HALO = WS_SSQ + (size_t)MP * 256;
constexpr size_t WS_SQKV = WS_HALO + (size_t)256 * 3 * 3072 * 2;
constexpr size_t WS_END = WS_SQKV + (size_t)128 * 3072 * 4;
static_assert(WS_END <= 268435456, "workspace map must fit 256 MiB");

constexpr size_t O_YP = 0, O_YS = 16777216, O_SPG = 16908288, O_SPQ = 17956864, O_SPC = 18030592, O_SSG = 18046976, O_SSQ = 34824192, O_SSC = 36003840, O_END = 36265984;

__device__ __forceinline__ float bf2f(unsigned short b) { return __uint_as_float((unsigned)b << 16); }
__device__ __forceinline__ unsigned short f2bf(float f) { return (unsigned short)(cvt_pk_bf16(f, 0.f) & 0xffffu); }
__device__ __forceinline__ void unpack8(const u32x4 w, float (&f)[8]) {
    f[0] = __uint_as_float(w.x << 16); f[1] = __uint_as_float(w.x & 0xffff0000u); f[2] = __uint_as_float(w.y << 16); f[3] = __uint_as_float(w.y & 0xffff0000u);
    f[4] = __uint_as_float(w.z << 16); f[5] = __uint_as_float(w.z & 0xffff0000u); f[6] = __uint_as_float(w.w << 16); f[7] = __uint_as_float(w.w & 0xffff0000u);
}
__device__ __forceinline__ u32x4 pack8(const float (&f)[8]) { u32x4 w; w.x = cvt_pk_bf16(f[0], f[1]); w.y = cvt_pk_bf16(f[2], f[3]); w.z = cvt_pk_bf16(f[4], f[5]); w.w = cvt_pk_bf16(f[6], f[7]); return w; }
__device__ __forceinline__ u32x4 pack44(const f32x4 a, const f32x4 b) { u32x4 w; w.x = cvt_pk_bf16(a[0], a[1]); w.y = cvt_pk_bf16(a[2], a[3]); w.z = cvt_pk_bf16(b[0], b[1]); w.w = cvt_pk_bf16(b[2], b[3]); return w; }
__device__ __forceinline__ float sigm(float x) { return __builtin_amdgcn_rcpf(1.f + __expf(-x)); }
__device__ __forceinline__ float silu(float x) { return x * sigm(x); }
__device__ __forceinline__ f32x4 sigm4(f32x4 v) { return (f32x4){sigm(v[0]), sigm(v[1]), sigm(v[2]), sigm(v[3])}; }
__device__ __forceinline__ f32x4 silu4(f32x4 v) { return (f32x4){silu(v[0]), silu(v[1]), silu(v[2]), silu(v[3])}; }
__device__ __forceinline__ f32x4 lo4(const u32x4 w) { return (f32x4){__uint_as_float(w.x << 16), __uint_as_float(w.x & 0xffff0000u), __uint_as_float(w.y << 16), __uint_as_float(w.y & 0xffff0000u)}; }
__device__ __forceinline__ f32x4 hi4(const u32x4 w) { return (f32x4){__uint_as_float(w.z << 16), __uint_as_float(w.z & 0xffff0000u), __uint_as_float(w.w << 16), __uint_as_float(w.w & 0xffff0000u)}; }
__device__ __forceinline__ float wave_sum(float v) {
#pragma unroll
    for (int o = 1; o < 64; o <<= 1) v += __shfl_xor(v, o);
    return v;
}

#define EPI_ROWS_BEGIN const int row0 = u.pm * 256 + wr * 64 + fr; _Pragma("unroll") for (int ai = 0; ai < 2; ++ai) _Pragma("unroll") for (int m = 0; m < 4; ++m) { const int r = row0 + ai * 128 + m * 16;
#define EPI_ROWS_END }

struct EpiGU {
    static constexpr bool PERM = true, AFTER_DRAIN = false;
    bf16* H;
    __device__ __forceinline__ void operator()(const f32x4 (&acc)[2][2][4][2], const pg8::Unit& u, int wr, int wc, int fr, int fq) const {
        const int col = u.pn * 128 + wc * 32 + 8 * fq;
        EPI_ROWS_BEGIN
            const f32x4 h0 = silu4(acc[ai][0][m][0]) * acc[ai][1][m][0], h1 = silu4(acc[ai][0][m][1]) * acc[ai][1][m][1];
            *(u32x4*)(H + (size_t)r * FF + col) = pack44(h0, h1);
        EPI_ROWS_END
    }
};
struct EpiRes {
    static constexpr bool PERM = true, AFTER_DRAIN = false;
    const float* inP; const float* inS; float* out; float alpha, scale;
    __device__ __forceinline__ void operator()(const f32x4 (&acc)[2][2][4][2], const pg8::Unit& u, int wr, int wc, int fr, int fq) const {
        const int col = u.pn * 256 + wc * 32 + 8 * fq;
        EPI_ROWS_BEGIN
            if (r < MREAL) {
                const float* ip = (r < MPROMPT ? inP + (size_t)r * D : inS + (size_t)(r - MPROMPT) * D) + col; float* op = out + (size_t)r * D + col;
#pragma unroll
                for (int bj = 0; bj < 2; ++bj)
#pragma unroll
                    for (int n = 0; n < 2; ++n) { const f32x4 x = *(const f32x4*)(ip + bj * 128 + 4 * n); *(f32x4*)(op + bj * 128 + 4 * n) = x * alpha + acc[ai][bj][m][n] * scale; }
            }
        EPI_ROWS_END
    }
};
struct EpiQKV {
    static constexpr bool PERM = true, AFTER_DRAIN = false;
    bf16* Q; bf16* halo; float* sp_qkv; float* ss_qkv;
    __device__ __forceinline__ void operator()(const f32x4 (&acc)[2][2][4][2], const pg8::Unit& u, int wr, int wc, int fr, int fq) const {
        const int colt = u.pn * 256, t = colt >> 10, cb = (colt & 1023) + wc * 32 + 8 * fq, gcol = colt + wc * 32 + 8 * fq;
        bf16* base = Q + (size_t)t * UEL;
        EPI_ROWS_BEGIN
#pragma unroll
            for (int bj = 0; bj < 2; ++bj) {
                const f32x4 a0 = acc[ai][bj][m][0], a1 = acc[ai][bj][m][1]; const u32x4 w = pack44(a0, a1);
                *(u32x4*)(base + (size_t)r * D + cb + bj * 128) = w;
                if (r < MPROMPT) { const int tt = r & 63;
                    if (tt >= 61) { *(u32x4*)(halo + ((size_t)(r >> 6) * 3 + (tt - 61)) * 3072 + gcol + bj * 128) = w;
                        if (((r >> 6) & 31) == 31) { float* o = sp_qkv + ((size_t)(r >> 11) * 3 + (tt - 61)) * 3072 + gcol + bj * 128; *(f32x4*)o = a0; *(f32x4*)(o + 4) = a1; } }
                } else if (r < MREAL) { float* o = ss_qkv + ((size_t)(r - MPROMPT) * 3 + 2) * 3072 + gcol + bj * 128; *(f32x4*)o = a0; *(f32x4*)(o + 4) = a1; }
            }
        EPI_ROWS_END
    }
};
struct EpiB {
    static constexpr bool PERM = true, AFTER_DRAIN = false;
    bf16* R0; const float* ssq; const float* w_onorm; float* sp_sc; float* ss_sc;
    __device__ __forceinline__ void operator()(const f32x4 (&acc)[2][2][4][2], const pg8::Unit& u, int wr, int wc, int fr, int fq) const {
        const int pn = u.pn, cw = wc * 32 + 8 * fq; bf16* const O = R0 + 2 * UEL; bf16* const CH = R0;
        if (pn < 4) {
            EPI_ROWS_BEGIN
#pragma unroll
                for (int bj = 0; bj < 2; ++bj) { const int head = 2 * pn + bj, c = pn * 256 + bj * 128 + cw;
                    const float* sp = ssq + ((size_t)r * 8 + head) * 8; const f32x4 s0 = *(const f32x4*)sp, s1 = *(const f32x4*)(sp + 4);
                    const float rstd = __builtin_amdgcn_rsqf(((s0[0] + s0[1]) + (s0[2] + s0[3]) + (s1[0] + s1[1]) + (s1[2] + s1[3])) * (1.f / 128.f) + 1e-6f);
                    const u32x4 ow = *(const u32x4*)(O + (size_t)r * D + c);
                    const f32x4 w0 = *(const f32x4*)(w_onorm + cw), w1 = *(const f32x4*)(w_onorm + cw + 4);
                    const f32x4 g0 = lo4(ow) * w0 * silu4(acc[ai][bj][m][0]) * rstd, g1 = hi4(ow) * w1 * silu4(acc[ai][bj][m][1]) * rstd;
                    *(u32x4*)(O + (size_t)r * D + c) = pack44(g0, g1); }
            EPI_ROWS_END
        } else if (pn < 12) {
            const int c = (pn - 4) * 128 + cw;
            EPI_ROWS_BEGIN
                const f32x4 h0 = acc[ai][0][m][0] * acc[ai][1][m][0], h1 = acc[ai][0][m][1] * acc[ai][1][m][1];
                *(u32x4*)(CH + (size_t)r * D + c) = pack44(h0, h1);
                if (r < MPROMPT) { const int tt = r & 2047; if (tt >= 2046) { float* o = sp_sc + ((size_t)(r >> 11) * 2 + (tt - 2046)) * 1024 + c; *(f32x4*)o = h0; *(f32x4*)(o + 4) = h1; } }
                else if (r < MREAL) { float* o = ss_sc + ((size_t)(r - MPROMPT) * 2 + 1) * 1024 + c; *(f32x4*)o = h0; *(f32x4*)(o + 4) = h1; }
            EPI_ROWS_END
        } else {
            const int kind = (pn - 12) >> 2; bf16* dst = R0 + (size_t)(kind == 0 ? 1 : kind + 2) * UEL; const int c0 = ((pn - 12) & 3) * 256 + cw;
            EPI_ROWS_BEGIN
#pragma unroll
                for (int bj = 0; bj < 2; ++bj) { f32x4 a0 = acc[ai][bj][m][0], a1 = acc[ai][bj][m][1]; if (kind) { a0 = sigm4(a0); a1 = sigm4(a1); }
                    *(u32x4*)(dst + (size_t)r * D + c0 + bj * 128) = pack44(a0, a1); }
            EPI_ROWS_END
        }
    }
};
struct EpiMul {
    static constexpr bool PERM = true, AFTER_DRAIN = false;
    bf16* G;
    __device__ __forceinline__ void operator()(const f32x4 (&acc)[2][2][4][2], const pg8::Unit& u, int wr, int wc, int fr, int fq) const {
        const int col = u.pn * 256 + wc * 32 + 8 * fq;
        EPI_ROWS_BEGIN
#pragma unroll
            for (int bj = 0; bj < 2; ++bj) { bf16* p = G + (size_t)r * D + col + bj * 128; const u32x4 g = *(const u32x4*)p;
                *(u32x4*)p = pack44(lo4(g) * acc[ai][bj][m][0], hi4(g) * acc[ai][bj][m][1]); }
        EPI_ROWS_END
    }
};
struct EpiMerge {
    static constexpr bool PERM = true, AFTER_DRAIN = false;
    const bf16* M1; bf16* S;
    __device__ __forceinline__ void operator()(const f32x4 (&acc)[2][2][4][2], const pg8::Unit& u, int wr, int wc, int fr, int fq) const {
        const int col = u.pn * 256 + wc * 32 + 8 * fq;
        EPI_ROWS_BEGIN
#pragma unroll
            for (int bj = 0; bj < 2; ++bj) { const size_t off = (size_t)r * D + col + bj * 128; const u32x4 g = *(const u32x4*)(S + off), m1 = *(const u32x4*)(M1 + off);
                *(u32x4*)(S + off) = pack44(lo4(m1) + lo4(g) * acc[ai][bj][m][0], hi4(m1) + hi4(g) * acc[ai][bj][m][1]); }
        EPI_ROWS_END
    }
};
struct EpiStore {
    static constexpr bool PERM = true, AFTER_DRAIN = false;
    bf16* P;
    __device__ __forceinline__ void operator()(const f32x4 (&acc)[2][2][4][2], const pg8::Unit& u, int wr, int wc, int fr, int fq) const {
        const int col = u.pn * 256 + wc * 32 + 8 * fq;
        EPI_ROWS_BEGIN
#pragma unroll
            for (int bj = 0; bj < 2; ++bj) *(u32x4*)(P + (size_t)r * D + col + bj * 128) = pack44(acc[ai][bj][m][0], acc[ai][bj][m][1]);
        EPI_ROWS_END
    }
};
struct EpiPle {
    static constexpr bool PERM = true, AFTER_DRAIN = false;
    float* RES; const bf16* PP;
    __device__ __forceinline__ void operator()(const f32x4 (&acc)[2][2][4][2], const pg8::Unit& u, int wr, int wc, int fr, int fq) const {
        const int col = u.pn * 256 + wc * 32 + 8 * fq;
        EPI_ROWS_BEGIN
            if (r < MREAL) {
#pragma unroll
                for (int bj = 0; bj < 2; ++bj) { const size_t off = (size_t)r * D + col + bj * 128; const u32x4 pp = *(const u32x4*)(PP + off);
                    const f32x4 x0 = *(const f32x4*)(RES + off), x1 = *(const f32x4*)(RES + off + 4);
                    *(f32x4*)(RES + off) = x0 * ALPHA + sigm4(acc[ai][bj][m][0]) * lo4(pp); *(f32x4*)(RES + off + 4) = x1 * ALPHA + sigm4(acc[ai][bj][m][1]) * hi4(pp); }
            }
        EPI_ROWS_END
    }
};

template <class EpiS>
__device__ __forceinline__ void sgemm_phase(LAS unsigned char* lds, const bf16* A, const bf16* Bt, int N, int K, const EpiS& E, int G) {
    const int tid = threadIdx.x, lane = tid & 63, wave = __builtin_amdgcn_readfirstlane(tid >> 6), li = lane & 15, lq = lane >> 4;
    const int ntask = (N >> 4) * 4, kper = K >> 3;
    LAS float* red = (LAS float*)lds;
    for (int task = blockIdx.x; task < ntask; task += G) {
        const int ct = task >> 2, rt = task & 3;
        const bf16* ap0 = A + (size_t)(rt * 32 + li) * K + wave * kper + 8 * lq; const bf16* ap1 = ap0 + (size_t)16 * K;
        const bf16* bp = Bt + (size_t)(ct * 16 + li) * K + wave * kper + 8 * lq;
        f32x4 acc0 = (f32x4){0.f, 0.f, 0.f, 0.f}, acc1 = acc0;
#pragma unroll 4
        for (int k = 0; k < kper; k += 32) { const bf16x8 b = *(const bf16x8*)(bp + k), a0 = *(const bf16x8*)(ap0 + k), a1 = *(const bf16x8*)(ap1 + k);
            acc0 = __builtin_amdgcn_mfma_f32_16x16x32_bf16(a0, b, acc0, 0, 0, 0); acc1 = __builtin_amdgcn_mfma_f32_16x16x32_bf16(a1, b, acc1, 0, 0, 0); }
#pragma unroll
        for (int r = 0; r < 4; ++r) { red[wave * 512 + (4 * lq + r) * 16 + li] = acc0[r]; red[wave * 512 + (16 + 4 * lq + r) * 16 + li] = acc1[r]; }
        __syncthreads();
        float v = 0.f;
#pragma unroll
        for (int w = 0; w < 8; ++w) v += red[w * 512 + tid];
        E(rt * 32 + (tid >> 4), ct * 16 + (tid & 15), v);
        __syncthreads();
    }
}
struct SRes { const float* in; float* out; float alpha, scale;
    __device__ __forceinline__ void operator()(int row, int c, float v) const { out[(size_t)row * D + c] = in[(size_t)row * D + c] * alpha + v * scale; } };
struct SMul { bf16* G;
    __device__ __forceinline__ void operator()(int row, int c, float v) const { bf16* p = G + (size_t)row * D + c; *p = f2bf(bf2f(*p) * v); } };
struct SMerge { const bf16* M1; bf16* S;
    __device__ __forceinline__ void operator()(int row, int c, float v) const { const size_t o = (size_t)row * D + c; S[o] = f2bf(bf2f(M1[o]) + bf2f(S[o]) * v); } };
struct SStore { bf16* P;
    __device__ __forceinline__ void operator()(int row, int c, float v) const { P[(size_t)row * D + c] = f2bf(v); } };
struct SPle { float* RES; const bf16* PP;
    __device__ __forceinline__ void operator()(int row, int c, float v) const { const size_t o = (size_t)row * D + c; RES[o] = RES[o] * ALPHA + sigm(v) * bf2f(PP[o]); } };

__device__ __forceinline__ void xpose_item(const float* W, int ldw, int c0, int K, int ncols, bf16* WT, int d0, int mode, int sel, LAS float* scr, int item, int lane) {
    const int nblk = ncols >> 5, kb = item / nblk, nb = item - kb * nblk, k0 = 64 * kb, n0 = 32 * nb;
    const int drow = mode ? d0 + 256 * (n0 >> 7) + 128 * sel + (n0 & 127) : d0 + n0;
#pragma unroll 8
    for (int i = 0; i < 32; ++i) { const int kk = 2 * i + (lane >> 5); scr[kk * 33 + (lane & 31)] = W[(size_t)(k0 + kk) * ldw + c0 + n0 + (lane & 31)]; }
    asm volatile("s_waitcnt lgkmcnt(0)" ::: "memory");
    const int c = lane & 7;
#pragma unroll
    for (int j = 0; j < 4; ++j) { const int n = (lane >> 3) + 8 * j; const LAS float* s = scr + (8 * c) * 33 + n;
        u32x4 o; o.x = cvt_pk_bf16(s[0 * 33], s[1 * 33]); o.y = cvt_pk_bf16(s[2 * 33], s[3 * 33]); o.z = cvt_pk_bf16(s[4 * 33], s[5 * 33]); o.w = cvt_pk_bf16(s[6 * 33], s[7 * 33]);
        *(u32x4*)(WT + (size_t)(drow + n) * K + k0 + 8 * c) = o; }
    asm volatile("s_waitcnt lgkmcnt(0)" ::: "memory");
}
#define XSEG(W, ldw, c0, K, ncols, WT, d0, mode, sel) { const int ni_ = ((K) / 64) * ((ncols) / 32); if (r_ < ni_) { xpose_item(W, ldw, c0, K, ncols, WT, d0, mode, sel, scr, r_, lane); continue; } r_ -= ni_; }

constexpr int N_PHASES_K = 19;
struct Args { const float* in[32]; float* out; unsigned char* ws; int ph_lo, ph_hi; };

template <bool WRITE_BF16, bool DO_BA>
__device__ __forceinline__ void ln_phase(float* RES, const float* g, const float* b, bf16* XB, const LAS float* wba, const float* A_log, const float* dt_bias, float* BETA, float* GG, int gw, int NGW, int lane) {
    f32x4 gv[4], bv[4];
#pragma unroll
    for (int j = 0; j < 4; ++j) { gv[j] = *((const f32x4*)g + 64 * j + lane); bv[j] = *((const f32x4*)b + 64 * j + lane); }
    for (int m = gw; m < MREAL; m += NGW) {
        f32x4* xr = (f32x4*)(RES + (size_t)m * D) + lane;
        f32x4 v[4]; float s = 0.f;
#pragma unroll
        for (int j = 0; j < 4; ++j) { v[j] = xr[64 * j]; s += (v[j][0] + v[j][1]) + (v[j][2] + v[j][3]); }
        const float mean = wave_sum(s) * (1.f / D); float s2 = 0.f;
#pragma unroll
        for (int j = 0; j < 4; ++j) { v[j] = v[j] - mean; s2 += (v[j][0] * v[j][0] + v[j][1] * v[j][1]) + (v[j][2] * v[j][2] + v[j][3] * v[j][3]); }
        const float rstd = 1.f / sqrtf(wave_sum(s2) * (1.f / D) + 1e-5f);
#pragma unroll
        for (int j = 0; j < 4; ++j) { v[j] = v[j] * rstd * gv[j] + bv[j]; xr[64 * j] = v[j]; }
        if (WRITE_BF16) {
            u32x2* o8 = (u32x2*)(XB + (size_t)m * D) + lane;
#pragma unroll
            for (int j = 0; j < 4; ++j) { u32x2 w; w.x = cvt_pk_bf16(v[j][0], v[j][1]); w.y = cvt_pk_bf16(v[j][2], v[j][3]); o8[64 * j] = w; }
        }
        if (DO_BA) {
            float mine = 0.f;
#pragma unroll
            for (int c = 0; c < 16; ++c) { float p = 0.f;
#pragma unroll
                for (int j = 0; j < 4; ++j) { const f32x4 w = *((const LAS f32x4*)(wba + c * 1024) + 64 * j + lane); p += (v[j][0] * w[0] + v[j][1] * w[1]) + (v[j][2] * w[2] + v[j][3] * w[3]); }
                p = wave_sum(p); if (lane == c) mine = p; }
            if (lane < 8) BETA[(size_t)m * 8 + lane] = sigm(mine);
            else if (lane < 16) { const int h = lane - 8; const float xx = mine + dt_bias[h]; const float sp = xx > 20.f ? xx : log1pf(expf(xx)); GG[(size_t)m * 8 + h] = -expf(A_log[h]) * sp; }
        }
    }
}

template <int W>
__device__ __forceinline__ void cvt_rows(const float* srcP, const float* srcS, bf16* dst, int gw, int NGW, int lane) {
    for (int m = gw; m < MP; m += NGW) {
        const float* src = m < MPROMPT ? srcP + (size_t)m * W : srcS + (size_t)(m - MPROMPT) * W;
#pragma unroll
        for (int j = 0; j < W / 256; ++j) { f32x4 v = (f32x4){0.f, 0.f, 0.f, 0.f}; if (m < MREAL) v = *((const f32x4*)src + 64 * j + lane);
            u32x2 w; w.x = cvt_pk_bf16(v[0], v[1]); w.y = cvt_pk_bf16(v[2], v[3]); *((u32x2*)(dst + (size_t)m * W) + 64 * j + lane) = w; }
    }
}

constexpr int PREP_HALF = 70144 + 256;
__device__ __forceinline__ void prep_unit(LAS unsigned char* lds, int uidx, bf16* Qg, bf16* Kg, bf16* Vg, bf16* KT, bf16* QK, const bf16* HALO, const float* wconv, const float* BETA, const float* GG, float* GC) {
    const int tid = threadIdx.x, hb = tid >> 8, tl = tid & 255, lane = tid & 63, wq = (tid >> 6) & 3;
    const int b = uidx >> 7, rem = uidx & 127, h = rem >> 4, cp = rem & 15, n = 2 * cp + hb;
    const int gcid = b * 32 + n, m0 = b * 2048 + n * 64;
    LAS unsigned char* L = lds + hb * PREP_HALF;
    LAS bf16* Qs = (LAS bf16*)L; LAS bf16* Ks = Qs + 64 * 136; LAS bf16* Vs = Ks + 64 * 136;
    LAS float* Af = (LAS float*)(L + 3 * 17408); LAS float* gcs = Af + 64 * 68; LAS float* betas = gcs + 64; LAS float* egcs = betas + 64;
#ifndef PREP_STEPS
#define PREP_STEPS 7
#endif
    if (PREP_STEPS & 1) {
        const int c8 = tl & 15, rg = tl >> 4, colh = h * 128 + 8 * c8;
#pragma unroll
        for (int mat = 0; mat < 3; ++mat) {
            const bf16* src = (mat == 0 ? Qg : (mat == 1 ? Kg : Vg));
            float xin[7][8];
#pragma unroll
            for (int i = 0; i < 7; ++i) { const int rr = 4 * rg - 3 + i; u32x4 w = (u32x4){0u, 0u, 0u, 0u};
                if (rr >= 0) w = *(const u32x4*)(src + (size_t)(m0 + rr) * D + colh);
                else if (n > 0) w = *(const u32x4*)(HALO + ((size_t)(gcid - 1) * 3 + (3 + rr)) * 3072 + mat * 1024 + colh);
                unpack8(w, xin[i]); }
            float y[4][8];
#pragma unroll
            for (int r = 0; r < 4; ++r)
#pragma unroll
                for (int e = 0; e < 8; ++e) y[r][e] = 0.f;
#pragma unroll
            for (int j = 0; j < 4; ++j) { const float* wp = wconv + (size_t)j * 3072 + mat * 1024 + colh; const f32x4 w0 = *(const f32x4*)wp, w1 = *(const f32x4*)(wp + 4);
#pragma unroll
                for (int r = 0; r < 4; ++r) {
#pragma unroll
                    for (int e = 0; e < 4; ++e) { y[r][e] += w0[e] * xin[r + j][e]; y[r][4 + e] += w1[e] * xin[r + j][4 + e]; } } }
#pragma unroll
            for (int r = 0; r < 4; ++r) {
                float ss = 0.f;
#pragma unroll
                for (int e = 0; e < 8; ++e) { y[r][e] = silu(y[r][e]); ss += y[r][e] * y[r][e]; }
                if (mat < 2) { ss += __shfl_xor(ss, 1); ss += __shfl_xor(ss, 2); ss += __shfl_xor(ss, 4); ss += __shfl_xor(ss, 8);
                    const float rs = __builtin_amdgcn_rsqf(ss + 1e-6f) * (mat == 0 ? 0.08838834764831845f : 1.f);
#pragma unroll
                    for (int e = 0; e < 8; ++e) y[r][e] *= rs; }
                LAS bf16* dstl = (mat == 0 ? Qs : (mat == 1 ? Ks : Vs)) + (4 * rg + r) * 136 + 8 * c8;
                *(LAS u32x4*)dstl = pack8(y[r]);
            }
        }
        if (tl < 64) { const size_t gi = (size_t)(m0 + tl) * 8 + h; const float be = BETA[gi]; float gsum = GG[gi];
#pragma unroll
            for (int d = 1; d < 64; d <<= 1) { const float t = __shfl_up(gsum, d); if (lane >= d) gsum += t; }
            gcs[tl] = gsum; betas[tl] = be; egcs[tl] = be * __expf(gsum); GC[gi] = gsum; }
    }
    __syncthreads();
    if (PREP_STEPS & 2) {
        const int c8 = tl & 15, rg = tl >> 4, colh = h * 128 + 8 * c8;
#pragma unroll
        for (int r = 0; r < 4; ++r) *(u32x4*)(Qg + (size_t)(m0 + 4 * rg + r) * D + colh) = *(const LAS u32x4*)(Qs + (4 * rg + r) * 136 + 8 * c8);
        { const int dk = tl & 127, rh = tl >> 7; bf16* dst = KT + ((size_t)(gcid * 8 + h) * 128 + dk) * 64 + 32 * rh;
#pragma unroll
            for (int q4 = 0; q4 < 4; ++q4) { u32x4 w; unsigned t0[4];
#pragma unroll
                for (int e = 0; e < 4; ++e) { const int i = 32 * rh + 8 * q4 + 2 * e; t0[e] = (unsigned)Ks[i * 136 + dk] | ((unsigned)Ks[(i + 1) * 136 + dk] << 16); }
                w.x = t0[0]; w.y = t0[1]; w.z = t0[2]; w.w = t0[3]; *(u32x4*)(dst + 8 * q4) = w; } }
        const int ti = wq, li = lane & 15, lq = lane >> 4;
        f32x4 accA[4], accQ[4];
#pragma unroll
        for (int tj = 0; tj < 4; ++tj) { accA[tj] = (f32x4){0.f, 0.f, 0.f, 0.f}; accQ[tj] = (f32x4){0.f, 0.f, 0.f, 0.f}; }
#pragma unroll
        for (int ks = 0; ks < 4; ++ks) {
            const bf16x8 aK = *(const LAS bf16x8*)(Ks + (16 * ti + li) * 136 + 32 * ks + 8 * lq), aQ = *(const LAS bf16x8*)(Qs + (16 * ti + li) * 136 + 32 * ks + 8 * lq);
#pragma unroll
            for (int tj = 0; tj < 4; ++tj) { const bf16x8 bK = *(const LAS bf16x8*)(Ks + (16 * tj + li) * 136 + 32 * ks + 8 * lq);
                accA[tj] = __builtin_amdgcn_mfma_f32_16x16x32_bf16(aK, bK, accA[tj], 0, 0, 0); accQ[tj] = __builtin_amdgcn_mfma_f32_16x16x32_bf16(aQ, bK, accQ[tj], 0, 0, 0); }
        }
        bf16* qkg = QK + (size_t)(gcid * 8 + h) * 4096;
#pragma unroll
        for (int tj = 0; tj < 4; ++tj)
#pragma unroll
            for (int r = 0; r < 4; ++r) { const int i = 16 * ti + 4 * lq + r, j = 16 * tj + li;
                const float dec = (i >= j) ? __expf(gcs[i] - gcs[j]) : 0.f;
                Af[j * 68 + i] = (i > j) ? betas[i] * dec * accA[tj][r] : 0.f;
                qkg[i * 64 + j] = f2bf(dec * accQ[tj][r]); }
    }
    __syncthreads();
    if (PREP_STEPS & 4) {
        const int c = tl & 127, which = tl >> 7;
        LAS bf16* src = which ? Ks : Vs;
        const LAS float* scp = which ? egcs : betas;
        bf16* dst = (which ? Kg : Vg) + (size_t)m0 * D + h * 128 + c;
#pragma unroll 1
        for (int I = 0; I < 4; ++I) {
            float acc[16];
#pragma unroll
            for (int r = 0; r < 16; ++r) acc[r] = bf2f(src[(16 * I + r) * 136 + c]) * scp[16 * I + r];
#pragma unroll 2
            for (int j = 0; j < 16 * I; ++j) {
                const float xj = bf2f(src[j * 136 + c]);
                const LAS f32x4* ap = (const LAS f32x4*)(Af + j * 68 + 16 * I);
                const f32x4 a0 = ap[0], a1 = ap[1], a2 = ap[2], a3 = ap[3];
#pragma unroll
                for (int e = 0; e < 4; ++e) { acc[e] -= a0[e] * xj; acc[4 + e] -= a1[e] * xj; acc[8 + e] -= a2[e] * xj; acc[12 + e] -= a3[e] * xj; }
            }
#pragma unroll
            for (int q = 0; q < 15; ++q) {
                const float xq = acc[q];
                const LAS f32x4* ap = (const LAS f32x4*)(Af + (16 * I + q) * 68 + 16 * I);
#pragma unroll
                for (int g4 = (q + 1) / 4; g4 < 4; ++g4) { const f32x4 av = ap[g4];
#pragma unroll
                    for (int e = 0; e < 4; ++e) if (4 * g4 + e > q) acc[4 * g4 + e] -= av[e] * xq; }
            }
#pragma unroll
            for (int r = 0; r < 16; ++r) { const unsigned short xb = f2bf(acc[r]); src[(16 * I + r) * 136 + c] = xb; dst[(size_t)(16 * I + r) * D] = xb; }
        }
    }
    __syncthreads();
}

__device__ __forceinline__ void prep_sample(const float* st_qkv, float* ss_qkv, const float* wconv, float* SQKV, int G) {
    const int tid = threadIdx.x, c8 = tid & 15;
    for (int g = blockIdx.x * 32 + (tid >> 4); g < 128 * 24; g += G * 32) {
        const int bs = g / 24, mh = g - bs * 24, mat = mh >> 3, gcol = mh * 128 + 8 * c8;
        float y[8];
#pragma unroll
        for (int e = 0; e < 8; ++e) y[e] = 0.f;
#pragma unroll
        for (int j = 0; j < 4; ++j) {
            const float* xp = (j < 3) ? st_qkv + ((size_t)bs * 3 + j) * 3072 + gcol : ss_qkv + ((size_t)bs * 3 + 2) * 3072 + gcol;
            const f32x4 x0 = *(const f32x4*)xp, x1 = *(const f32x4*)(xp + 4);
            const float* wp = wconv + (size_t)j * 3072 + gcol; const f32x4 w0 = *(const f32x4*)wp, w1 = *(const f32x4*)(wp + 4);
#pragma unroll
            for (int e = 0; e < 4; ++e) { y[e] += w0[e] * x0[e]; y[4 + e] += w1[e] * x1[e]; }
            if (j >= 1 && j < 3) { float* o = ss_qkv + ((size_t)bs * 3 + (j - 1)) * 3072 + gcol; *(f32x4*)o = x0; *(f32x4*)(o + 4) = x1; }
        }
        float ss = 0.f;
#pragma unroll
        for (int e = 0; e < 8; ++e) { y[e] = silu(y[e]); ss += y[e] * y[e]; }
        if (mat < 2) { ss += __shfl_xor(ss, 1); ss += __shfl_xor(ss, 2); ss += __shfl_xor(ss, 4); ss += __shfl_xor(ss, 8);
            const float rs = __builtin_amdgcn_rsqf(ss + 1e-6f) * (mat == 0 ? 0.08838834764831845f : 1.f);
#pragma unroll
            for (int e = 0; e < 8; ++e) y[e] *= rs; }
        float* o = SQKV + (size_t)bs * 3072 + gcol; *(f32x4*)o = (f32x4){y[0], y[1], y[2], y[3]}; *(f32x4*)(o + 4) = (f32x4){y[4], y[5], y[6], y[7]};
    }
}

__device__ __forceinline__ void scan_unit(LAS unsigned char* lds, int uidx, const bf16* Qg, const bf16* Kg, bf16* Vg, const bf16* KT, const bf16* QK, const float* GC, float* SSQ, float* sp_gdn) {
    const int tid = threadIdx.x, lane = tid & 63, s = __builtin_amdgcn_readfirstlane(tid >> 6);
    const int xc = uidx & 7, yy = uidx >> 3, slab = yy & 3, bh = xc * 8 + (yy >> 2), b = bh >> 3, h = bh & 7;
    LAS bf16* St = (LAS bf16*)lds; LAS bf16* Vt = St + 2 * 32 * 136; LAS bf16* Vts = Vt + 32 * 72;
    const int ti = s >> 1, c = s & 1, li = lane & 15, lq = lane >> 4;
    f32x4 S0 = (f32x4){0.f, 0.f, 0.f, 0.f}, S1 = S0;
    const int ucol = h * 128 + slab * 32 + 16 * c + li;
    for (int n = 0; n < 32; ++n) {
        const int gcid = b * 32 + n, m0 = b * 2048 + n * 64;
        bf16x8 wA[4], qA[4], qkA[2], kA[2];
        { const bf16* wrow = Kg + (size_t)(m0 + 16 * ti + li) * D + h * 128 + 8 * lq; const bf16* qrow = Qg + (size_t)(m0 + 16 * ti + li) * D + h * 128 + 8 * lq;
#pragma unroll
          for (int ks = 0; ks < 4; ++ks) { wA[ks] = *(const bf16x8*)(wrow + 32 * ks); qA[ks] = *(const bf16x8*)(qrow + 32 * ks); }
          const bf16* qkrow = QK + ((size_t)(gcid * 8 + h) * 64 + 16 * ti + li) * 64 + 8 * lq; const bf16* ktrow = KT + ((size_t)(gcid * 8 + h) * 128 + 16 * s + li) * 64 + 8 * lq;
#pragma unroll
          for (int k2 = 0; k2 < 2; ++k2) { qkA[k2] = *(const bf16x8*)(qkrow + 32 * k2); kA[k2] = *(const bf16x8*)(ktrow + 32 * k2); } }
        float uval[4], gcr[4]; const int rowb = m0 + 16 * ti + 4 * lq;
#pragma unroll
        for (int r = 0; r < 4; ++r) { uval[r] = bf2f(Vg[(size_t)(rowb + r) * D + ucol]); gcr[r] = GC[(size_t)(rowb + r) * 8 + h]; }
        const float gl = GC[(size_t)(m0 + 63) * 8 + h];
        LAS bf16* Sb = St + (n & 1) * 32 * 136;
        { u32x2 w; w.x = cvt_pk_bf16(S0[0], S0[1]); w.y = cvt_pk_bf16(S0[2], S0[3]); *(LAS u32x2*)(Sb + li * 136 + 16 * s + 4 * lq) = w;
          w.x = cvt_pk_bf16(S1[0], S1[1]); w.y = cvt_pk_bf16(S1[2], S1[3]); *(LAS u32x2*)(Sb + (16 + li) * 136 + 16 * s + 4 * lq) = w; }
        __syncthreads();
        bf16x8 bS[4]; f32x4 acc = (f32x4){0.f, 0.f, 0.f, 0.f};
#pragma unroll
        for (int ks = 0; ks < 4; ++ks) { bS[ks] = *(const LAS bf16x8*)(Sb + (16 * c + li) * 136 + 32 * ks + 8 * lq); acc = __builtin_amdgcn_mfma_f32_16x16x32_bf16(wA[ks], bS[ks], acc, 0, 0, 0); }
        { float vn[4], vs[4];
#pragma unroll
          for (int r = 0; r < 4; ++r) { vn[r] = uval[r] - acc[r]; vs[r] = vn[r] * __expf(gl - gcr[r]); }
          u32x2 w; w.x = cvt_pk_bf16(vn[0], vn[1]); w.y = cvt_pk_bf16(vn[2], vn[3]); *(LAS u32x2*)(Vt + (16 * c + li) * 72 + 16 * ti + 4 * lq) = w;
          w.x = cvt_pk_bf16(vs[0], vs[1]); w.y = cvt_pk_bf16(vs[2], vs[3]); *(LAS u32x2*)(Vts + (16 * c + li) * 72 + 16 * ti + 4 * lq) = w; }
        __syncthreads();
        f32x4 o = (f32x4){0.f, 0.f, 0.f, 0.f};
#pragma unroll
        for (int ks = 0; ks < 4; ++ks) o = __builtin_amdgcn_mfma_f32_16x16x32_bf16(qA[ks], bS[ks], o, 0, 0, 0);
#pragma unroll
        for (int r = 0; r < 4; ++r) o[r] *= __expf(gcr[r]);
#pragma unroll
        for (int k2 = 0; k2 < 2; ++k2) { const bf16x8 bV = *(const LAS bf16x8*)(Vt + (16 * c + li) * 72 + 32 * k2 + 8 * lq); o = __builtin_amdgcn_mfma_f32_16x16x32_bf16(qkA[k2], bV, o, 0, 0, 0); }
#pragma unroll
        for (int r = 0; r < 4; ++r) { Vg[(size_t)(rowb + r) * D + ucol] = f2bf(o[r]); float sq = o[r] * o[r];
            sq += __shfl_xor(sq, 1); sq += __shfl_xor(sq, 2); sq += __shfl_xor(sq, 4); sq += __shfl_xor(sq, 8);
            if (li == 0) SSQ[((size_t)(rowb + r) * 8 + h) * 8 + slab * 2 + c] = sq; }
        const float eg = __expf(gl); S0 = S0 * eg; S1 = S1 * eg;
#pragma unroll
        for (int k2 = 0; k2 < 2; ++k2) { const bf16x8 b0 = *(const LAS bf16x8*)(Vts + li * 72 + 32 * k2 + 8 * lq), b1 = *(const LAS bf16x8*)(Vts + (16 + li) * 72 + 32 * k2 + 8 * lq);
            S0 = __builtin_amdgcn_mfma_f32_16x16x32_bf16(kA[k2], b0, S0, 0, 0, 0); S1 = __builtin_amdgcn_mfma_f32_16x16x32_bf16(kA[k2], b1, S1, 0, 0, 0); }
    }
    float* so = sp_gdn + ((size_t)(b * 8 + h) * 128 + 16 * s + 4 * lq) * 128 + slab * 32 + li;
#pragma unroll
    for (int r = 0; r < 4; ++r) { so[(size_t)r * 128] = S0[r]; so[(size_t)r * 128 + 16] = S1[r]; }
    __syncthreads();
}

__device__ __forceinline__ void gdn_sample_unit(LAS unsigned char* lds, int su, const float* state, float* ss_gdn, const float* SQKV, const float* BETA, const float* GG, bf16* Vg, float* SSQ) {
    const int tid = threadIdx.x, bs = su >> 3, h = su & 7, kq = tid >> 5, vq = tid & 31, m = MPROMPT + bs;
    const float* Sin = state + (size_t)su * 16384; float* Sout = ss_gdn + (size_t)su * 16384;
    f32x4 Sv[8];
#pragma unroll
    for (int i = 0; i < 8; ++i) Sv[i] = *(const f32x4*)(Sin + (size_t)(8 * kq + i) * 128 + 4 * vq);
    const float* qv = SQKV + (size_t)bs * 3072 + h * 128; const float* kv = qv + 1024; const float* vv = qv + 2048;
    float kk[8], qq[8];
#pragma unroll
    for (int i = 0; i < 8; ++i) { kk[i] = kv[8 * kq + i]; qq[i] = qv[8 * kq + i]; }
    const float a = expf(GG[(size_t)m * 8 + h]), be = BETA[(size_t)m * 8 + h];
    f32x4 p = (f32x4){0.f, 0.f, 0.f, 0.f};
#pragma unroll
    for (int i = 0; i < 8; ++i) { Sv[i] = Sv[i] * a; p += Sv[i] * kk[i]; }
    LAS f32x4* red = (LAS f32x4*)lds;
    red[kq * 32 + vq] = p; __syncthreads();
    f32x4 kvs = (f32x4){0.f, 0.f, 0.f, 0.f};
#pragma unroll
    for (int g = 0; g < 16; ++g) kvs += red[g * 32 + vq];
    const f32x4 dd = (*(const f32x4*)(vv + 4 * vq) - kvs) * be;
    f32x4 po = (f32x4){0.f, 0.f, 0.f, 0.f};
#pragma unroll
    for (int i = 0; i < 8; ++i) { Sv[i] += dd * kk[i]; po += Sv[i] * qq[i]; *(f32x4*)(Sout + (size_t)(8 * kq + i) * 128 + 4 * vq) = Sv[i]; }
    __syncthreads();
    red[kq * 32 + vq] = po; __syncthreads();
    if (tid < 64) {
        float ssum = 0.f;
        if (tid < 32) { f32x4 o = (f32x4){0.f, 0.f, 0.f, 0.f};
#pragma unroll
            for (int g = 0; g < 16; ++g) o += red[g * 32 + tid];
            u32x2 w; w.x = cvt_pk_bf16(o[0], o[1]); w.y = cvt_pk_bf16(o[2], o[3]); *(u32x2*)(Vg + (size_t)m * D + h * 128 + 4 * tid) = w;
            ssum = (o[0] * o[0] + o[1] * o[1]) + (o[2] * o[2] + o[3] * o[3]); }
        ssum = wave_sum(ssum);
        if (tid < 8) SSQ[((size_t)m * 8 + h) * 8 + tid] = tid == 0 ? ssum : 0.f;
    }
    __syncthreads();
}

__device__ __forceinline__ void conv3_phase(const bf16* CH, bf16* Bg, const float* wsc, const float* st_sc, float* ss_sc, int G) {
    const size_t total = (size_t)MREAL * 128;
    for (size_t it = (size_t)blockIdx.x * 512 + threadIdx.x; it < total; it += (size_t)G * 512) {
        const int m = (int)(it >> 7), c = (int)(it & 127) * 8;
        float x0[8], x1[8], x2[8], bg[8], w0[8], w1[8], w2[8];
        unpack8(*(const u32x4*)(CH + (size_t)m * D + c), x2); unpack8(*(const u32x4*)(Bg + (size_t)m * D + c), bg);
#pragma unroll
        for (int e = 0; e < 8; ++e) { w0[e] = wsc[c + e]; w1[e] = wsc[1024 + c + e]; w2[e] = wsc[2048 + c + e]; x0[e] = 0.f; x1[e] = 0.f; }
        if (m < MPROMPT) { const int t = m & 2047;
            if (t >= 1) unpack8(*(const u32x4*)(CH + (size_t)(m - 1) * D + c), x1);
            if (t >= 2) unpack8(*(const u32x4*)(CH + (size_t)(m - 2) * D + c), x0);
        } else { const int bs = m - MPROMPT; const float* s0 = st_sc + ((size_t)bs * 2) * 1024 + c; float* o = ss_sc + ((size_t)bs * 2) * 1024 + c;
#pragma unroll
            for (int e = 0; e < 8; ++e) { x0[e] = s0[e]; x1[e] = s0[1024 + e]; o[e] = s0[1024 + e]; } }
        float y[8];
#pragma unroll
        for (int e = 0; e < 8; ++e) y[e] = bg[e] * (w0[e] * x0[e] + w1[e] * x1[e] + w2[e] * x2[e]);
        *(u32x4*)(Bg + (size_t)m * D + c) = pack8(y);
    }
}

#define XB_TMO      128
#define XB_XCNT(j)  (256  + 64 * (j))
#define XB_XSUB(j)  (1280 + 64 * (j))
#define XB_XGEN(j)  (2304 + 64 * (j))
#define XB_TOP      3328
#define XB_TOPGEN   3392
#define XCD_BAR_WORDS 3456
#define XB_SPIN_CAP (1u << 18)

__device__ __forceinline__ unsigned xb_ld(unsigned* p)              { return __hip_atomic_load(p, __ATOMIC_RELAXED, __HIP_MEMORY_SCOPE_AGENT); }
__device__ __forceinline__ unsigned xb_add(unsigned* p, unsigned v) { return __hip_atomic_fetch_add(p, v, __ATOMIC_RELAXED, __HIP_MEMORY_SCOPE_AGENT); }
__device__ __forceinline__ unsigned xb_xcc_id() { return (unsigned)__builtin_amdgcn_s_getreg((3 << 11) | 20) & 0xFu; }
#define XB_SPIN(cond, bar) do { unsigned _sp = 0; while (cond) { __builtin_amdgcn_s_sleep(1); \
    if ((++_sp & 255u) == 0u) { if (xb_ld(&(bar)[XB_TMO])) break; if (_sp > XB_SPIN_CAP) { atomicAdd(&(bar)[XB_TMO], 1u); break; } } } } while (0)

struct XcdBarrier {
    unsigned* bar; unsigned x;
    volatile LAS unsigned* st;
};

__device__ __forceinline__ XcdBarrier xcd_barrier_post(unsigned* bar, volatile LAS unsigned* st) {
    XcdBarrier b; b.bar = bar; b.x = xb_xcc_id(); b.st = st;
    if (threadIdx.x == 0) (void)xb_add(&bar[XB_XCNT(b.x)], 1u);
    return b;
}
__device__ __forceinline__ void xcd_barrier_complete(unsigned* bar, unsigned x, unsigned& nloc, unsigned& nx) {
    const unsigned G = gridDim.x * gridDim.y * gridDim.z;
    unsigned sum, cnt, mine, sp = 0u;
    for (;;) {
        sum = 0u; cnt = 0u; mine = 0u;
#pragma unroll
        for (unsigned j = 0; j < 16; ++j) { const unsigned c = xb_ld(&bar[XB_XCNT(j)]); sum += c; cnt += (c > 0u) ? 1u : 0u; mine = (j == x) ? c : mine; }
        if (sum == G) break;
        __builtin_amdgcn_s_sleep(1);
        if ((++sp & 255u) == 0u) { if (xb_ld(&bar[XB_TMO])) break; if (sp > XB_SPIN_CAP) { atomicAdd(&bar[XB_TMO], 1u); break; } }
    }
    nloc = mine > 0u ? mine : 1u; nx = cnt > 0u ? cnt : 1u;
}

__device__ __forceinline__ void xcd_barrier(const XcdBarrier& b) {
    asm volatile("s_waitcnt vmcnt(0)" ::: "memory");
    __syncthreads();
    if (threadIdx.x == 0) {
        unsigned* bar = b.bar;
        __builtin_amdgcn_s_waitcnt(0);
        unsigned nloc = b.st[0], nx = b.st[1];
        if (nloc == 0u) { xcd_barrier_complete(bar, b.x, nloc, nx); b.st[0] = nloc; b.st[1] = nx; }
        const unsigned old = xb_add(&bar[XB_XSUB(b.x)], 1u);
        const unsigned gen = old / nloc;
        if (old + 1u == (gen + 1u) * nloc) {
            __builtin_amdgcn_fence(__ATOMIC_RELEASE, "agent");
            asm volatile("s_waitcnt vmcnt(0)" ::: "memory");
            const unsigned og = xb_add(&bar[XB_TOP], 1u);
            const unsigned tg = og / nx;
            if (og + 1u == (tg + 1u) * nx) xb_add(&bar[XB_TOPGEN], 1u);
            else XB_SPIN(xb_ld(&bar[XB_TOPGEN]) == tg, bar);
            __builtin_amdgcn_fence(__ATOMIC_ACQUIRE, "agent");
            xb_add(&bar[XB_XGEN(b.x)], 1u);
            asm volatile("s_waitcnt vmcnt(0)" ::: "memory");
        } else {
            XB_SPIN(xb_ld(&bar[XB_XGEN(b.x)]) == gen, bar);
            __builtin_amdgcn_fence(__ATOMIC_ACQUIRE, "agent");
            asm volatile("s_waitcnt vmcnt(0)" ::: "memory");
        }
    }
    __syncthreads();
}

__device__ __forceinline__ unsigned long long arg_q(int k) { const __attribute__((address_space(4))) unsigned long long* b = (const __attribute__((address_space(4))) unsigned long long*)__builtin_amdgcn_kernarg_segment_ptr(); asm volatile("" : "+s"(b)); return b[k]; }
__device__ __forceinline__ const float* arg_in(int k) { return (const float*)arg_q(k); }
__global__ void __launch_bounds__(NWAVES * 64, 2) mega_fwd(Args args) {
    extern __shared__ __attribute__((aligned(16))) unsigned char lds_raw[];
    LAS unsigned char* lds = (LAS unsigned char*)lds_raw;
    cg::grid_group grid = cg::this_grid();
    const int tid = threadIdx.x, lane = tid & 63, wave = __builtin_amdgcn_readfirstlane(tid >> 6);
    const int G = gridDim.x, gw = blockIdx.x * NWAVES + wave, NGW = G * NWAVES;
#define ws  ((unsigned char*)arg_q(33))
#define out ((float*)arg_q(32))
#define WGU ((bf16*)(ws + WS_WGU))
#define WD ((bf16*)(ws + WS_WD))
#define WQKV ((bf16*)(ws + WS_WQKV))
#define WINB ((bf16*)(ws + WS_WINB))
#define WPG ((bf16*)(ws + WS_WPG))
#define WPS ((bf16*)(ws + WS_WPS))
#define WO ((bf16*)(ws + WS_WO))
#define WPLEG ((bf16*)(ws + WS_WPLEG))
#define WPLEP ((bf16*)(ws + WS_WPLEP))
#define WBA ((float*)(ws + WS_WBA))
#define XB ((bf16*)(ws + WS_XB))
#define R0 ((bf16*)(ws + WS_R))
#define R1 (R0 + UEL)
#define R2 (R0 + 2 * UEL)
#define R3 (R0 + 3 * UEL)
#define R4 (R0 + 4 * UEL)
#define BETA ((float*)(ws + WS_BETA))
#define GG ((float*)(ws + WS_GG))
#define GC ((float*)(ws + WS_GC))
#define SSQ ((float*)(ws + WS_SSQ))
#define HALO ((bf16*)(ws + WS_HALO))
#define SQKV ((float*)(ws + WS_SQKV))
#define RES out
    const int lo = args.ph_lo, hi = args.ph_hi;
    volatile LAS unsigned* bar_st = (volatile LAS unsigned*)(lds + 147200);
    if (tid == 0) { bar_st[0] = 0u; bar_st[1] = 0u; }
    __syncthreads();
    const XcdBarrier bar = xcd_barrier_post((unsigned*)ws, bar_st);
#ifndef PH_MASK
#define PH_MASK 0x7ffff
#endif
#define IN(k) (((PH_MASK >> (k)) & 1) && lo <= (k) && (k) < hi)
#define SEAM(k) do { if (IN(k) && IN((k) + 1)) xcd_barrier(bar); } while (0)
    if (hi > N_PHASES_K) { asm volatile("s_waitcnt vmcnt(0) lgkmcnt(0)" ::: "memory"); __syncthreads(); grid.sync(); __builtin_amdgcn_fence(__ATOMIC_ACQUIRE, "agent"); asm volatile("s_waitcnt vmcnt(0)" ::: "memory"); }
#define SOFF ((size_t)MPROMPT * D)
#define GEMM(EpiT, E, Aop, Bop, M_, N_, K_) do { int k_ = K_; asm volatile("" : "+s"(k_)); pg8::Gemm g_{Aop, Bop, M_, N_, k_}; pg8::StaticOrder S_; S_.init(M_, N_, G, (int)blockIdx.x); \
        pg8::gemm_phase<EpiT, pg8::StaticOrder, true, true>(lds, g_, S_, E); } while (0)

    if (IN(0)) {
        LAS float* scr = (LAS float*)(lds + wave * 16384);
        const float* w_in = arg_in(12);
        constexpr int NIT = 2 * (16 * 88) + 44 * 32 + 16 * 96 + 16 * 32 * 6 + 4 * 16 * 32 + 4 * 32;
        for (int it = gw; it < NIT; it += NGW) {
            int r_ = it;
            XSEG(arg_in(7), FF, 0, 1024, FF, WGU, 0, 1, 0)
            XSEG(arg_in(8), FF, 0, 1024, FF, WGU, 0, 1, 1)
            XSEG(arg_in(9), D, 0, FF, D, WD, 0, 0, 0)
            XSEG(w_in, INW, 0, 1024, 3072, WQKV, 0, 0, 0)
            XSEG(w_in, INW, 3072, 1024, 1024, WINB, 0, 0, 0)
            XSEG(w_in, INW, 5136, 1024, 1024, WINB, 1024, 1, 0)
            XSEG(w_in, INW, 6160, 1024, 1024, WINB, 1024, 1, 1)
            XSEG(w_in, INW, 4112, 1024, 1024, WINB, 3072, 0, 0)
            XSEG(w_in, INW, 7184, 1024, 1024, WINB, 4096, 0, 0)
            XSEG(w_in, INW, 8208, 1024, 1024, WINB, 5120, 0, 0)
            XSEG(arg_in(17), D, 0, 1024, 1024, WPG, 0, 0, 0)
            XSEG(arg_in(19), D, 0, 1024, 1024, WPS, 0, 0, 0)
            XSEG(arg_in(20), D, 0, 1024, 1024, WO, 0, 0, 0)
            XSEG(arg_in(28), D, 0, 1024, 1024, WPLEG, 0, 0, 0)
            XSEG(arg_in(29), D, 0, 256, 1024, WPLEP, 0, 0, 0)
        }
        for (int e = blockIdx.x * 512 + tid; e < 16 * 1024; e += G * 512) { const int c = e >> 10, k = e & 1023; WBA[e] = w_in[(size_t)k * INW + 4096 + c]; }
        cvt_rows<1024>(arg_in(0), arg_in(1), XB, gw, NGW, lane);
    }
    SEAM(0);
    if (IN(1)) { EpiGU E{R0}; GEMM(EpiGU, E, XB, WGU, MP, 5632, 1024); }
    SEAM(1);
    if (IN(2)) { { SRes ES{arg_in(1), RES + SOFF, ALPHA, 0.5f}; sgemm_phase(lds, R0 + (size_t)MPROMPT * FF, WD, 1024, FF, ES, G); }
        EpiRes E{arg_in(0), arg_in(1), RES, ALPHA, 0.5f}; GEMM(EpiRes, E, R0, WD, MPROMPT, 1024, FF); }
    SEAM(2);
    if (IN(3)) {
        for (int e = tid; e < 16 * 1024 / 4; e += 512) ((LAS f32x4*)lds)[e] = ((const f32x4*)WBA)[e];
        __syncthreads();
        ln_phase<true, true>(RES, arg_in(10), arg_in(11), XB, (const LAS float*)lds, arg_in(14), arg_in(15), BETA, GG, gw, NGW, lane);
        __syncthreads();
    }
    SEAM(3);
    if (IN(4)) { EpiQKV E{R0, HALO, out + O_SPQ, out + O_SSQ}; GEMM(EpiQKV, E, XB, WQKV, MP, 3072, 1024); }
    SEAM(4);
    if (IN(5)) {
        for (int u = blockIdx.x; u < 1024; u += G) prep_unit(lds, u, R0, R1, R2, R3, R4, HALO, arg_in(13), BETA, GG, GC);
        prep_sample(arg_in(5), out + O_SSQ, arg_in(13), SQKV, G);
    }
    SEAM(5);
    if (IN(6)) {
        for (int u = blockIdx.x; u < 256; u += G) scan_unit(lds, u, R0, R1, R2, R3, R4, GC, SSQ, out + O_SPG);
        for (int su = blockIdx.x; su < 1024; su += G) gdn_sample_unit(lds, su, arg_in(4), out + O_SSG, SQKV, BETA, GG, R2, SSQ);
    }
    SEAM(6);
    if (IN(7)) { EpiB E{R0, SSQ, arg_in(16), out + O_SPC, out + O_SSC}; GEMM(EpiB, E, XB, WINB, MP, 6144, 1024); }
    SEAM(7);
    if (IN(8)) conv3_phase(R0, R1, arg_in(18), arg_in(6), out + O_SSC, G);
    SEAM(8);
    if (IN(9)) { { SMul ES{R3 + SOFF}; sgemm_phase(lds, R2 + SOFF, WPG, 1024, 1024, ES, G); }
        EpiMul E{R3}; GEMM(EpiMul, E, R2, WPG, MPROMPT, 1024, 1024); }
    SEAM(9);
    if (IN(10)) { { SMerge ES{R3 + SOFF, R4 + SOFF}; sgemm_phase(lds, R1 + SOFF, WPS, 1024, 1024, ES, G); }
        EpiMerge E{R3, R4}; GEMM(EpiMerge, E, R1, WPS, MPROMPT, 1024, 1024); }
    SEAM(10);
    if (IN(11)) { { SRes ES{RES + SOFF, RES + SOFF, ALPHA, 1.0f}; sgemm_phase(lds, R4 + SOFF, WO, 1024, 1024, ES, G); }
        EpiRes E{RES, RES + (size_t)MPROMPT * D, RES, ALPHA, 1.0f}; GEMM(EpiRes, E, R4, WO, MPROMPT, 1024, 1024); }
    SEAM(11);
    if (IN(12)) {
        ln_phase<true, false>(RES, arg_in(21), arg_in(22), XB, nullptr, nullptr, nullptr, nullptr, nullptr, gw, NGW, lane);
        LAS float* scr = (LAS float*)(lds + wave * 16384);
        constexpr int NIT = 2 * (16 * 88) + 44 * 32;
        for (int it = gw; it < NIT; it += NGW) {
            int r_ = it;
            XSEG(arg_in(23), FF, 0, 1024, FF, WGU, 0, 1, 0)
            XSEG(arg_in(24), FF, 0, 1024, FF, WGU, 0, 1, 1)
            XSEG(arg_in(25), D, 0, FF, D, WD, 0, 0, 0)
        }
    }
    SEAM(12);
    if (IN(13)) { EpiGU E{R0}; GEMM(EpiGU, E, XB, WGU, MP, 5632, 1024); }
    SEAM(13);
    if (IN(14)) { { SRes ES{RES + SOFF, RES + SOFF, ALPHA, 0.5f}; sgemm_phase(lds, R0 + (size_t)MPROMPT * FF, WD, 1024, FF, ES, G); }
        EpiRes E{RES, RES + (size_t)MPROMPT * D, RES, ALPHA, 0.5f}; GEMM(EpiRes, E, R0, WD, MPROMPT, 1024, FF); }
    SEAM(14);
    if (IN(15)) {
        ln_phase<true, false>(RES, arg_in(26), arg_in(27), XB, nullptr, nullptr, nullptr, nullptr, nullptr, gw, NGW, lane);
        cvt_rows<256>(arg_in(2), arg_in(3), R1, gw, NGW, lane);
    }
    SEAM(15);
    if (IN(16)) { { SStore ES{R0 + SOFF}; sgemm_phase(lds, R1 + (size_t)MPROMPT * 256, WPLEP, 1024, 256, ES, G); }
        EpiStore E{R0}; GEMM(EpiStore, E, R1, WPLEP, MPROMPT, 1024, 256); }
    SEAM(16);
    if (IN(17)) { { SPle ES{RES + SOFF, R0 + SOFF}; sgemm_phase(lds, XB + SOFF, WPLEG, 1024, 1024, ES, G); }
        EpiPle E{RES, R0}; GEMM(EpiPle, E, XB, WPLEG, MPROMPT, 1024, 1024); }
    SEAM(17);
    if (IN(18)) ln_phase<false, false>(RES, arg_in(30), arg_in(31), nullptr, nullptr, nullptr, nullptr, nullptr, nullptr, gw, NGW, lane);
#undef IN
#undef SEAM
#undef GEMM
#undef SOFF
}
#undef ws
#undef out
#undef WGU
#undef WD
#undef WQKV
#undef WINB
#undef WPG
#undef WPS
#undef WO
#undef WPLEG
#undef WPLEP
#undef WBA
#undef XB
#undef R0
#undef R1
#undef R2
#undef R3
#undef R4
#undef BETA
#undef GG
#undef GC
#undef SSQ
#undef HALO
#undef SQKV
#undef RES


constexpr int N_PHASES = 19;
#ifndef MK_SPLIT
#define MK_SPLIT 0
#endif

extern "C" void kernel_launch(void* const* d_in, const int* in_sizes, int n_in, void* d_out, int out_size, void* d_ws, size_t ws_size, hipStream_t stream) {
    static int grid = 0;
    if (grid == 0) {
        if (n_in != 32 || out_size != (int)O_END || ws_size < WS_END) {
            fprintf(stderr, "kernel_launch: unexpected sizes n_in %d out %d ws %zu (need %zu)\n", n_in, out_size, ws_size, (size_t)WS_END);
            grid = -1;
        } else {
            int dev = 0, cus = 0, per_cu = 0;
            hipGetDevice(&dev); hipDeviceGetAttribute(&cus, hipDeviceAttributeMultiprocessorCount, dev);
            hipFuncSetAttribute((const void*)mega_fwd, hipFuncAttributeMaxDynamicSharedMemorySize, LDS_BYTES);
            hipOccupancyMaxActiveBlocksPerMultiprocessor(&per_cu, (const void*)mega_fwd, NWAVES * 64, LDS_BYTES);
            if (per_cu < 1) { fprintf(stderr, "kernel_launch: occupancy query says %d blocks per CU\n", per_cu); grid = -1; }
            else grid = cus;
        }
    }
    if (grid < 0) { (void)hipMemsetAsync(d_out, 0xFF, (size_t)out_size * 4, stream); return; }
    Args a{};
    for (int i = 0; i < 32; ++i) a.in[i] = (const float*)d_in[i];
    a.out = (float*)d_out; a.ws = (unsigned char*)d_ws;
#if MK_SPLIT
    for (int p = 0; p < N_PHASES; ++p) { a.ph_lo = p; a.ph_hi = p + 1; hipLaunchKernelGGL(mega_fwd, dim3(grid), dim3(NWAVES * 64), LDS_BYTES, stream, a); }
#else
    (void)hipMemsetAsync(d_ws, 0, 16384, stream);
    void* kargs[] = {&a};
#ifdef DBG_REP
    a.ph_lo = 0; a.ph_hi = DBG_REP;
    (void)hipLaunchCooperativeKernel((const void*)mega_fwd, dim3(grid), dim3(NWAVES * 64), kargs, LDS_BYTES, stream);
    (void)hipMemsetAsync(d_ws, 0, 16384, stream);
#endif
    a.ph_lo = 0; a.ph_hi = N_PHASES;
    hipError_t e = hipLaunchCooperativeKernel((const void*)mega_fwd, dim3(grid), dim3(NWAVES * 64), kargs, LDS_BYTES, stream);
    if (e != hipSuccess) fprintf(stderr, "cooperative launch failed: %s (grid %d)\n", hipGetErrorString(e), grid);
#endif
}
```
